# Optimizing an MI355X kernel written in HIP

```python
import jax, jax.numpy as jnp
from jax import lax
import numpy as np

D_MODEL = 1024
BATCH = 16
SEQ = 2048
DEPTH = 2

HEAD_DIM = 64
N_HEADS_A = 8
N_HEADS_B = 8
D_A = N_HEADS_A * HEAD_DIM
D_B = N_HEADS_B * HEAD_DIM
D_MIX = D_A + D_B
D_IN = 4 * D_A + 4 * D_B
SPLIT_POINTS = (D_A, 2 * D_A, 3 * D_A, 4 * D_A,
                4 * D_A + D_B, 4 * D_A + 2 * D_B, 4 * D_A + 3 * D_B)
DILATED_PATTERNS = ((128, 1), (512, 4), (2048, 16))
MOBA_BLOCK = 256
MOBA_TOPK = 3
MOBA_QCHUNK = 128
ROPE_THETA = 500000.0
ROPE_DIM = HEAD_DIM // 4
RMS_EPS = 1e-6
NEG_INF = -1e30

kernel_name = "hymba_dilated_moba_sandwich_adaln"


def rms_norm(x, g):
    x32 = x.astype(jnp.float32)
    y = x32 * lax.rsqrt(jnp.mean(x32 * x32, axis=-1, keepdims=True) + RMS_EPS)
    return (y * g.astype(jnp.float32)).astype(x.dtype)


def rope_tables(positions):
    inv_freq = ROPE_THETA ** (-jnp.arange(0, ROPE_DIM, 2, dtype=jnp.float32) / ROPE_DIM)
    ang = positions.astype(jnp.float32)[:, None, :, None] * inv_freq
    return jnp.cos(ang), jnp.sin(ang)


def apply_partial_rope(t, cos, sin):
    r = ROPE_DIM // 2
    cos = cos.astype(t.dtype)
    sin = sin.astype(t.dtype)
    t1, t2, rest = t[..., :r], t[..., r:ROPE_DIM], t[..., ROPE_DIM:]
    return jnp.concatenate([t1 * cos - t2 * sin, t2 * cos + t1 * sin, rest], axis=-1)


def dilated_pattern(q, k, v, window, dilation):
    B, H, S, hd = q.shape
    n = window // dilation
    span = n * dilation
    s_pad = -(-S // span) * span
    L = s_pad // dilation

    def strided(t):
        t = jnp.pad(t, ((0, 0), (0, 0), (0, s_pad - S), (0, 0)))
        t = t.reshape(B, H, L, dilation, hd).transpose(0, 1, 3, 2, 4)
        return t.reshape(B, H, dilation, L // n, n, hd)

    qb, kb, vb = strided(q), strided(k), strided(v)
    nblk = L // n

    def with_prev(t):
        prev = jnp.pad(t, ((0, 0), (0, 0), (0, 0), (1, 0), (0, 0), (0, 0)))[:, :, :, :-1]
        return jnp.concatenate([prev, t], axis=4)

    kw, vw = with_prev(kb), with_prev(vb)
    s = jnp.einsum('bhrnqd,bhrnkd->bhrnqk', qb, kw,
                   preferred_element_type=jnp.float32) * (hd ** -0.5)
    qi = jnp.arange(n)[:, None]
    kj = jnp.arange(2 * n)[None, :]
    delta = qi + n - kj
    blk = jnp.arange(nblk)[:, None, None]
    valid = (delta >= 0) & (delta <= n) & (blk * n + kj - n >= 0)
    s = jnp.where(valid, s, NEG_INF)
    m = jnp.max(s, axis=-1, keepdims=True)
    p = jnp.exp(s - m)
    denom = jnp.sum(p, axis=-1)
    num = jnp.einsum('bhrnqk,bhrnkd->bhrnqd', p.astype(v.dtype), vw,
                     preferred_element_type=jnp.float32)
    o = num / denom[..., None]
    lse = m[..., 0] + jnp.log(denom)
    o = o.reshape(B, H, dilation, L, hd).transpose(0, 1, 3, 2, 4).reshape(B, H, s_pad, hd)[:, :, :S]
    lse = lse.reshape(B, H, dilation, L).transpose(0, 1, 3, 2).reshape(B, H, s_pad)[:, :, :S]
    return o, lse


def dilated_mixture_attention(q, k, v):
    outs, lses = [], []
    for window, dilation in DILATED_PATTERNS:
        o, lse = dilated_pattern(q, k, v, window, dilation)
        outs.append(o)
        lses.append(lse)
    alpha = jax.nn.softmax(jnp.stack(lses, axis=0), axis=0)
    o = jnp.einsum('pbhs,pbhsd->bhsd', alpha, jnp.stack(outs, axis=0))
    return o.astype(q.dtype)


def moba_attention(q, k, v):
    B, H, S, hd = q.shape
    blk = MOBA_BLOCK
    s_pad = -(-S // blk) * blk
    nb = s_pad // blk
    padw = ((0, 0), (0, 0), (0, s_pad - S), (0, 0))
    q, k, v = jnp.pad(q, padw), jnp.pad(k, padw), jnp.pad(v, padw)
    kb = k.reshape(B, H, nb, blk, hd)
    vb = v.reshape(B, H, nb, blk, hd)
    scale = hd ** -0.5
    topk = min(MOBA_TOPK, nb)

    kmean = jnp.mean(kb.astype(jnp.float32), axis=3)
    gate = jnp.einsum('bhsd,bhnd->bhsn', q.astype(jnp.float32), kmean)
    own = jnp.arange(s_pad) // blk
    past = jnp.arange(nb)[None, :] < own[:, None]
    gate = jnp.where(past, gate, NEG_INF)
    _, sel = lax.top_k(gate, topk)

    qc = MOBA_QCHUNK
    nchunk = s_pad // qc
    q_chunks = q.reshape(B, H, nchunk, qc, hd)
    sel_chunks = sel.reshape(B, H, nchunk, qc, topk)
    hidx = jnp.arange(H)[:, None, None]

    def body(idx):
        b = idx // nchunk
        c = idx % nchunk
        q_c = q_chunks[b][:, c]
        sel_c = sel_chunks[b][:, c]
        kb_b, vb_b = kb[b], vb[b]
        qpos = c * qc + jnp.arange(qc)
        ob = (c * qc) // blk
        k_own = lax.dynamic_index_in_dim(kb_b, ob, axis=1, keepdims=False)
        v_own = lax.dynamic_index_in_dim(vb_b, ob, axis=1, keepdims=False)
        kpos = ob * blk + jnp.arange(blk)
        s_own = jnp.einsum('hqd,hkd->hqk', q_c, k_own,
                           preferred_element_type=jnp.float32) * scale
        s_own = jnp.where(kpos[None, :] <= qpos[:, None], s_own, NEG_INF)
        k_sel = kb_b[hidx, sel_c]
        v_sel = vb_b[hidx, sel_c]
        s_sel = jnp.einsum('hqd,hqnkd->hqnk', q_c, k_sel,
                           preferred_element_type=jnp.float32) * scale
        valid = jnp.arange(topk)[None, :] < jnp.minimum(qpos // blk, topk)[:, None]
        s_sel = jnp.where(valid[None, :, :, None], s_sel, NEG_INF)
        scores = jnp.concatenate([s_own, s_sel.reshape(H, qc, topk * blk)], axis=-1)
        p = jax.nn.softmax(scores, axis=-1)
        p_own = p[..., :blk].astype(v.dtype)
        p_sel = p[..., blk:].reshape(H, qc, topk, blk).astype(v.dtype)
        o = (jnp.einsum('hqk,hkd->hqd', p_own, v_own, preferred_element_type=jnp.float32)
             + jnp.einsum('hqnk,hqnkd->hqd', p_sel, v_sel, preferred_element_type=jnp.float32))
        return o.astype(q.dtype)

    out = lax.map(body, jnp.arange(B * nchunk))
    out = out.reshape(B, nchunk, H, qc, hd).transpose(0, 2, 1, 3, 4).reshape(B, H, s_pad, hd)
    return out[:, :, :S]


def hybrid_layer(x, c, cos, sin, pre_g, post_g, w_ada, b_ada, w_in, w_out):
    B, S, _ = x.shape
    mod = jnp.einsum('bd,de->be', jax.nn.silu(c), w_ada) + b_ada
    shift, scale, gate = jnp.split(mod, 3, axis=-1)
    h = rms_norm(x, pre_g) * (1 + scale[:, None, :]) + shift[:, None, :]
    proj = jnp.einsum('bsd,de->bse', h, w_in)
    qa, ka, va, ga, qb, kb, vb, gb = jnp.split(proj, SPLIT_POINTS, axis=-1)

    def heads(t, nh):
        return t.reshape(B, S, nh, HEAD_DIM).transpose(0, 2, 1, 3)

    def merge(t):
        return t.transpose(0, 2, 1, 3).reshape(B, S, -1)

    qa = apply_partial_rope(heads(qa, N_HEADS_A), cos, sin)
    ka = apply_partial_rope(heads(ka, N_HEADS_A), cos, sin)
    qb = apply_partial_rope(heads(qb, N_HEADS_B), cos, sin)
    kb = apply_partial_rope(heads(kb, N_HEADS_B), cos, sin)
    o_a = merge(dilated_mixture_attention(qa, ka, heads(va, N_HEADS_A))) * jax.nn.silu(ga)
    o_b = merge(moba_attention(qb, kb, heads(vb, N_HEADS_B))) * jax.nn.silu(gb)
    y = jnp.einsum('bse,ed->bsd', jnp.concatenate([o_a, o_b], axis=-1), w_out)
    y = rms_norm(y, post_g)
    return x + gate[:, None, :] * y


def setup_inputs(seed: int = 0) -> dict:
    key = jax.random.key(seed)
    ks = jax.random.split(key, 11)
    x = jax.random.normal(ks[0], (BATCH, SEQ, D_MODEL), jnp.float32)
    c = jax.random.normal(ks[1], (BATCH, D_MODEL), jnp.float32)
    offset = jax.random.randint(ks[2], (BATCH, 1), 0, 4096, dtype=jnp.int32)
    positions = (jnp.arange(SEQ, dtype=jnp.int32)[None, :] + offset).astype(jnp.int32)
    pre_norm_gain = 1.0 + 0.02 * jax.random.normal(ks[3], (DEPTH, D_MODEL), jnp.float32)
    post_norm_gain = 1.0 + 0.02 * jax.random.normal(ks[4], (DEPTH, D_MODEL), jnp.float32)
    w_ada = jax.random.normal(ks[5], (DEPTH, D_MODEL, 3 * D_MODEL), jnp.float32) * D_MODEL ** -0.5
    b_ada = 0.01 * jax.random.normal(ks[6], (DEPTH, 3 * D_MODEL), jnp.float32)
    w_in = jax.random.normal(ks[7], (DEPTH, D_MODEL, D_IN), jnp.float32) * D_MODEL ** -0.5
    w_out = jax.random.normal(ks[8], (DEPTH, D_MIX, D_MODEL), jnp.float32) * D_MIX ** -0.5
    return {"x": x, "c": c, "positions": positions,
            "pre_norm_gain": pre_norm_gain, "post_norm_gain": post_norm_gain,
            "w_ada": w_ada, "b_ada": b_ada, "w_in": w_in, "w_out": w_out}


def reference(x, c, positions, pre_norm_gain, post_norm_gain, w_ada, b_ada, w_in, w_out):
    cos, sin = rope_tables(positions)
    for layer in range(DEPTH):
        x = hybrid_layer(x, c, cos, sin, pre_norm_gain[layer], post_norm_gain[layer],
                         w_ada[layer], b_ada[layer], w_in[layer], w_out[layer])
    return x
```

```cpp
#include <hip/hip_runtime.h>
#include <hip/hip_bf16.h>
#include <cmath>
#include <cstdio>
#include <cstdint>

constexpr int NB = 16, SEQ = 2048, DM = 1024, NH = 8, HD = 64, DIN = 4096, MROWS = NB * SEQ, DEPTH = 2;
constexpr float RMS_EPS = 1e-6f;
constexpr float C2 = 0.125f * 1.4426950408889634f;
constexpr float NEGBIG = -1.0e30f;
constexpr size_t TSZ = (size_t)NB * NH * SEQ * HD;
namespace pg8 {
#define PG8_LAS __attribute__((address_space(3)))
typedef unsigned short bf16_t;
typedef short bf16x8 __attribute__((ext_vector_type(8)));
typedef float f32x4 __attribute__((ext_vector_type(4)));
typedef unsigned u32x4 __attribute__((ext_vector_type(4)));
constexpr int BM = 256, BK = 64, HALF = 128, HTB = HALF * BK * 2  , STAGE_BYTES = 8 * HTB, NXCD = 8, WGM = 8;

__host__ __device__ __forceinline__ int lds_byte(int r, int c) { const int st = (r >> 4) * 2 + (c >> 5), rr = r & 15, cc = c & 31, ob = rr * 64 + cc * 2; return st * 1024 + (ob ^ (((ob >> 9) & 1) << 5)); }
__host__ __device__ __forceinline__ void stage_rc(int b, int& R, int& C) { const int st = b / 1024, sb = b % 1024, swz = sb ^ (((sb >> 9) & 1) << 5); R = (st >> 1) * 16 + swz / 64; C = (st & 1) * 32 + (swz % 64) / 2; }
__host__ __device__ __forceinline__ int perm32(int rho) { const int n = rho >> 4, i = rho & 15; return 8 * (i >> 2) + 4 * n + (i & 3); }

struct Unit { int pm, pn; };
struct Gemm { const bf16_t* A; const bf16_t* Bt; int M, N, K; };

struct StaticOrder {
    int nM, nN, nwg, G, c, mix;
    __host__ __device__ void init(int M, int N, int G_, int c_, int mix_ = 0) { nM = M / BM; nN = N / BM; nwg = nM * nN; G = G_; c = c_; mix = mix_; }
    __host__ __device__ bool next(int i, Unit& u) const {
        const long L = (long)i * G + c; if (L >= nwg) return false;
        int wgid = (int)L; { const int q = nwg / NXCD, r = nwg % NXCD, xcd = wgid % NXCD, off = wgid / NXCD; wgid = (xcd < r ? xcd * (q + 1) : r * (q + 1) + (xcd - r) * q) + off; }
        const int nig = WGM * nN, gid = wgid / nig, fm = gid * WGM, gsz = (nM - fm) < WGM ? (nM - fm) : WGM;
        u.pm = fm + ((wgid % nig) % gsz); u.pn = (wgid % nig) / gsz;
        if (mix) { const int t = u.pn >> 2, j = u.pn & 3; u.pn = 8 * (j >> 1) + 2 * ((t + j) & 3) + (j & 1); }
        return true;
    }
    __device__ __forceinline__ void a_ready(const Unit&) const {}
    __device__ __forceinline__ void done(const Unit&) const {}
};
__device__ __forceinline__ unsigned cvt_pk_bf16(float lo, float hi) { unsigned r; asm volatile("v_cvt_pk_bf16_f32 %0, %1, %2" : "=v"(r) : "v"(lo), "v"(hi)); return r; }
typedef _Float16 f16x8 __attribute__((ext_vector_type(8)));
constexpr int EPI_WST = 16 * 144;
struct EpiPlain {
    static constexpr bool PERM = true, AFTER_DRAIN = false, HPW = true, PREFETCH = false;
    bf16_t* O; int ldc; PG8_LAS unsigned char* st;
    __device__ __forceinline__ void operator()(const f32x4 (&acc)[2][2][4][2], const Unit& u, int wr, int wc, int fr_, int fq_) const {
        int tl_ = threadIdx.x; asm volatile("" : "+v"(tl_)); const int fr = tl_ & 15, fq = (tl_ >> 4) & 3; (void)fr_; (void)fq_;
        const int lane = fq * 16 + fr;
        PG8_LAS unsigned char* wst = st + (wr * 4 + wc) * EPI_WST;
        PG8_LAS unsigned char* wp = wst + fr * 144 + fq * 16; const PG8_LAS unsigned char* rp = wst + (lane >> 3) * 144 + (lane & 7) * 16;
        bf16_t* ob = O + (size_t)(u.pm * BM + wr * 64 + (lane >> 3)) * ldc + u.pn * BM + wc * 64 + (lane & 7) * 8;
        u32x4 rq[2];
#pragma unroll
        for (int it = 0; it < 9; ++it) { const int ai = (it & 7) >> 2, m = it & 3;
            u32x4 rn[2];
            if (it < 8) {
#pragma unroll
                for (int bj = 0; bj < 2; ++bj) { const f32x4 v0 = acc[ai][bj][m][0], v1 = acc[ai][bj][m][1];
                    u32x4 w; w.x = cvt_pk_bf16(v0[0], v0[1]); w.y = cvt_pk_bf16(v0[2], v0[3]); w.z = cvt_pk_bf16(v1[0], v1[1]); w.w = cvt_pk_bf16(v1[2], v1[3]);
                    *(PG8_LAS u32x4*)(wp + bj * 64) = w; }
#pragma unroll
                for (int h = 0; h < 2; ++h) rn[h] = *(const PG8_LAS u32x4*)(rp + h * 8 * 144);
            }
            if (it > 0) { const int pa = (it - 1) >> 2, pm_ = (it - 1) & 3;
#pragma unroll
                for (int h = 0; h < 2; ++h) *(u32x4*)(ob + (size_t)(pa * HALF + pm_ * 16 + h * 8) * ldc) = rq[h]; }
            if (it < 8) { rq[0] = rn[0]; rq[1] = rn[1]; }
        }
    }
};
struct EpiProj {
    static constexpr bool PERM = true, AFTER_DRAIN = false, HPW = true, PREFETCH = true;
    bf16_t* qkv; const _Float16* rope; PG8_LAS unsigned char* st; PG8_LAS unsigned char* rl;
    __device__ __forceinline__ void prefetch(const Unit& u, int wid) const {
        if (((u.pn >> 1) & 3) < 2) { int tl_ = threadIdx.x; asm volatile("" : "+v"(tl_));
            __builtin_amdgcn_global_load_lds((const unsigned*)(rope + (size_t)u.pm * 256 * 16 + wid * 512 + (tl_ & 63) * 8), (PG8_LAS unsigned*)(rl + wid * 1024), 16, 0, 0); }
    }
    __device__ __forceinline__ void operator()(const f32x4 (&acc)[2][2][4][2], const Unit& u, int wr, int wc, int fr_, int fq_) const {
        int tl_ = threadIdx.x; asm volatile("" : "+v"(tl_)); const int fr = tl_ & 15, fq = (tl_ >> 4) & 3; (void)fr_; (void)fq_;
        const int tensor = u.pn >> 1, kind = tensor & 3, lane = fq * 16 + fr;
        const int b = u.pm >> 3, sb = (u.pm & 7) * 256 + wr * 64;
        const bool roped = (kind < 2);
        const float sg = (fq == 0) ? -1.f : 1.f;
        PG8_LAS unsigned char* wst = st + (wr * 4 + wc) * EPI_WST;
        PG8_LAS unsigned char* wp = wst + fr * 144 + fq * 16; const PG8_LAS unsigned char* rp = wst + (lane >> 3) * 144 + (lane & 7) * 16;
        const PG8_LAS unsigned char* rr = rl + (wr * 64 + fr) * 32;
        bf16_t* ob = qkv + (size_t)tensor * TSZ + ((size_t)(b * 8 + (u.pn & 1) * 4 + wc) * 2048 + sb) * 64 + lane * 8;
        u32x4 rq[2];
#pragma unroll
        for (int it = 0; it < 9; ++it) { const int ai = (it & 7) >> 2, m = it & 3;
            u32x4 rn[2];
            if (it < 8) {
#pragma unroll
                for (int bj = 0; bj < 2; ++bj) {
                    f32x4 v0 = acc[ai][bj][m][0], v1 = acc[ai][bj][m][1];
                    if (roped && bj == 0) {
                        const f16x8 c8 = *(const PG8_LAS f16x8*)(rr + (ai * HALF + m * 16) * 32), s8 = *(const PG8_LAS f16x8*)(rr + (ai * HALF + m * 16) * 32 + 16);
                        f32x4 p0, p1;
#pragma unroll
                        for (int c = 0; c < 4; ++c) { p0[c] = __shfl_xor(v0[c], 16); p1[c] = __shfl_xor(v1[c], 16); }
                        if (fq < 2) {
                            const f32x4 c0 = {(float)c8[0], (float)c8[1], (float)c8[2], (float)c8[3]}, c1 = {(float)c8[4], (float)c8[5], (float)c8[6], (float)c8[7]};
                            const f32x4 s0 = {(float)s8[0], (float)s8[1], (float)s8[2], (float)s8[3]}, s1 = {(float)s8[4], (float)s8[5], (float)s8[6], (float)s8[7]};
                            v0 = v0 * c0 + sg * (p0 * s0); v1 = v1 * c1 + sg * (p1 * s1); }
                    }
                    if (kind == 0) { v0 = v0 * C2; v1 = v1 * C2; }
                    if (kind == 3) {
#pragma unroll
                        for (int c = 0; c < 4; ++c) { v0[c] = v0[c] * __builtin_amdgcn_rcpf(1.f + __builtin_amdgcn_exp2f(-1.4426950408889634f * v0[c])); v1[c] = v1[c] * __builtin_amdgcn_rcpf(1.f + __builtin_amdgcn_exp2f(-1.4426950408889634f * v1[c])); }
                    }
                    u32x4 w; w.x = cvt_pk_bf16(v0[0], v0[1]); w.y = cvt_pk_bf16(v0[2], v0[3]); w.z = cvt_pk_bf16(v1[0], v1[1]); w.w = cvt_pk_bf16(v1[2], v1[3]);
                    *(PG8_LAS u32x4*)(wp + bj * 64) = w;
                }
#pragma unroll
                for (int h = 0; h < 2; ++h) rn[h] = *(const PG8_LAS u32x4*)(rp + h * 8 * 144);
            }
            if (it > 0) { const int pa = (it - 1) >> 2, pm_ = (it - 1) & 3;
#pragma unroll
                for (int h = 0; h < 2; ++h) __builtin_nontemporal_store(rq[h], (u32x4*)(ob + (size_t)(pa * HALF + pm_ * 16) * 64 + h * 512)); }
            if (it < 8) { rq[0] = rn[0]; rq[1] = rn[1]; }
        }
    }
};
template <class Epi, class Sched, bool ALIGN_EPI = false, bool SP2 = false>
__device__ __forceinline__ void gemm_phase(PG8_LAS unsigned char* lds, const Gemm g, const Sched& S, const Epi& E) {
    int tid_o = threadIdx.x; asm volatile("" : "+v"(tid_o));
    const int tid = tid_o, wid = __builtin_amdgcn_readfirstlane(tid >> 6), lane = tid & 63, wr = wid >> 2, wc = wid & 3, fr = lane & 15, fq = lane >> 4;
    const int K = g.K, nt = K / BK;
    unsigned voffA[2], voffB[2]; int aoff, boff;
#define PG8_LANE_OFFS() do { int t_ = threadIdx.x; asm volatile("" : "+v"(t_)); const int fr_ = t_ & 15, fq_ = (t_ >> 4) & 3; \
        _Pragma("unroll") for (int i = 0; i < 2; ++i) { int R, C; stage_rc(t_ * 16 + i * 8192, R, C); const int Rb = Epi::PERM ? ((R & ~31) + perm32(R & 31)) : R; \
            voffA[i] = (unsigned)(R * K + C) * 2u; voffB[i] = Epi::HPW ? (unsigned)(((R >> 5) * 64 + perm32(R & 31)) * K + C) * 2u : (unsigned)(Rb * K + C) * 2u; } \
        aoff = lds_byte(wr * 64 + fr_, fq_ * 8); boff = lds_byte(wc * 32 + fr_, fq_ * 8); } while (0)
    PG8_LANE_OFFS();
    const size_t kstep = (size_t)(BK * 2);
    const size_t hstep = (size_t)HALF * K * 2;
    const size_t bstep = Epi::HPW ? (size_t)32 * K * 2 : hstep;
    const size_t tstep = 2 * hstep;
    const unsigned ldsw = (unsigned)wid * 1024u;
#define PG8_SA(b, h) (((b) * 2 + (h)) * HTB)
#define PG8_SB(b, h) ((4 + (b) * 2 + (h)) * HTB)
#define PG8_STAGE(bufoff, gbase, voff) do { _Pragma("unroll") for (int _i = 0; _i < 2; ++_i) \
        __builtin_amdgcn_global_load_lds((const unsigned*)((const char*)(gbase) + (voff)[_i]), (PG8_LAS unsigned*)(lds + (bufoff) + ldsw + _i * 8192), 16, 0, 0); } while (0)
#define PG8_LDA(dst, b, h) do { _Pragma("unroll") for (int m = 0; m < 4; ++m) _Pragma("unroll") for (int k = 0; k < 2; ++k) dst[m][k] = *(const PG8_LAS bf16x8*)(lds + PG8_SA(b, h) + aoff + m * 2048 + k * 1024); } while (0)
#define PG8_LDB(dst, b, h) do { _Pragma("unroll") for (int n = 0; n < 2; ++n) _Pragma("unroll") for (int k = 0; k < 2; ++k) dst[n][k] = *(const PG8_LAS bf16x8*)(lds + PG8_SB(b, h) + boff + n * 2048 + k * 1024); } while (0)
#define PG8_MMA(ai, bj, At, Bt) do { __builtin_amdgcn_s_setprio(1); _Pragma("unroll") for (int m = 0; m < 4; ++m) _Pragma("unroll") for (int n = 0; n < 2; ++n) _Pragma("unroll") for (int k = 0; k < 2; ++k) \
        acc[ai][bj][m][n] = __builtin_amdgcn_mfma_f32_16x16x32_bf16(Bt[n][k], At[m][k], acc[ai][bj][m][n], 0, 0, 0); __builtin_amdgcn_s_setprio(0); } while (0)
#define PG8_WAIT_V(n) asm volatile("s_waitcnt vmcnt(" #n ")" ::: "memory")
#define PG8_WAIT_L(n) asm volatile("s_waitcnt lgkmcnt(" #n ")" ::: "memory")
#define PG8_BAR __builtin_amdgcn_s_barrier()
#define PG8_SCHED __builtin_amdgcn_sched_barrier(0)
    Unit cur, nxt; int ui = 0;
    if (!S.next(0, cur)) return;
    f32x4 acc[2][2][4][2];
#pragma unroll
    for (int a = 0; a < 2; ++a)
#pragma unroll
        for (int b = 0; b < 2; ++b)
#pragma unroll
            for (int m = 0; m < 4; ++m)
#pragma unroll
                for (int n = 0; n < 2; ++n) acc[a][b][m][n] = (f32x4){0.f, 0.f, 0.f, 0.f};
    bf16x8 At[4][2], B0[2][2], B1[2][2];
    const char* cA = (const char*)g.A + (size_t)cur.pm * tstep; const char* cB = (const char*)g.Bt + (size_t)cur.pn * tstep;
    S.a_ready(cur);
    if constexpr (SP2) {
        PG8_STAGE(PG8_SB(0, 0), cB, voffB); PG8_STAGE(PG8_SB(0, 1), cB + bstep, voffB); PG8_STAGE(PG8_SA(0, 0), cA, voffA); PG8_STAGE(PG8_SA(0, 1), cA + hstep, voffA);
        if (wr == 1) PG8_BAR;
        PG8_WAIT_V(2); PG8_BAR;
        PG8_STAGE(PG8_SB(1, 0), cB + kstep, voffB); PG8_STAGE(PG8_SA(1, 0), cA + kstep, voffA); PG8_STAGE(PG8_SB(1, 1), cB + bstep + kstep, voffB);
        PG8_WAIT_V(6); PG8_BAR;
    } else {
        PG8_STAGE(PG8_SB(0, 0), cB, voffB); PG8_STAGE(PG8_SA(0, 0), cA, voffA); PG8_STAGE(PG8_SB(0, 1), cB + bstep, voffB); PG8_STAGE(PG8_SA(0, 1), cA + hstep, voffA);
        if (wr == 1) PG8_BAR;
        PG8_WAIT_V(4); PG8_BAR;
        PG8_STAGE(PG8_SB(1, 0), cB + kstep, voffB); PG8_STAGE(PG8_SA(1, 0), cA + kstep, voffA); PG8_STAGE(PG8_SB(1, 1), cB + bstep + kstep, voffB);
        PG8_WAIT_V(6); PG8_BAR;
    }
    for (;;) {
        const bool has_next = S.next(ui + 1, nxt);
        const char* nA = has_next ? (const char*)g.A + (size_t)nxt.pm * tstep : cA; const char* nB = has_next ? (const char*)g.Bt + (size_t)nxt.pn * tstep : cB;
        for (int t = 0; t < nt; t += 2) {
            const bool last = (t == nt - 2);
            if constexpr (Epi::PREFETCH) { if (t == 2) E.prefetch(cur, wid); }
            const char* a1 = cA + (size_t)(t + 1) * kstep;
            const char* a2 = last ? nA : cA + (size_t)(t + 2) * kstep; const char* b2 = last ? nB : cB + (size_t)(t + 2) * kstep;
            const char* a3 = a2 + kstep; const char* b3 = b2 + kstep;
            if (last && has_next) S.a_ready(nxt);
            if constexpr (SP2) {
            PG8_LDB(B0, 0, 0); PG8_LDB(B1, 0, 1); PG8_SCHED; PG8_LDA(At, 0, 0); PG8_STAGE(PG8_SA(1, 1), a1 + hstep, voffA);
            PG8_WAIT_V(8); PG8_WAIT_L(0); PG8_BAR; PG8_MMA(0, 0, At, B0); PG8_MMA(0, 1, At, B1); PG8_BAR; PG8_SCHED;
            PG8_LDA(At, 0, 1); PG8_STAGE(PG8_SB(0, 0), b2, voffB); PG8_STAGE(PG8_SB(0, 1), b2 + bstep, voffB); PG8_STAGE(PG8_SA(0, 0), a2, voffA);
            PG8_WAIT_V(8); PG8_WAIT_L(0); PG8_BAR; PG8_MMA(1, 0, At, B0); PG8_MMA(1, 1, At, B1); PG8_BAR; PG8_SCHED;
            PG8_LDB(B0, 1, 0); PG8_LDB(B1, 1, 1); PG8_SCHED; PG8_LDA(At, 1, 0); PG8_STAGE(PG8_SA(0, 1), a2 + hstep, voffA);
            PG8_WAIT_V(8); PG8_WAIT_L(0); PG8_BAR; PG8_MMA(0, 0, At, B0); PG8_MMA(0, 1, At, B1); PG8_BAR; PG8_SCHED;
            PG8_LDA(At, 1, 1); PG8_STAGE(PG8_SB(1, 0), b3, voffB); PG8_STAGE(PG8_SB(1, 1), b3 + bstep, voffB); PG8_STAGE(PG8_SA(1, 0), a3, voffA);
            PG8_WAIT_V(8); PG8_WAIT_L(0); PG8_BAR; PG8_MMA(1, 0, At, B0); PG8_MMA(1, 1, At, B1); PG8_BAR; PG8_SCHED;
            } else {
            PG8_LDB(B0, 0, 0); PG8_SCHED; PG8_LDA(At, 0, 0); PG8_STAGE(PG8_SA(1, 1), a1 + hstep, voffA);
            PG8_WAIT_L(8); PG8_BAR; PG8_WAIT_L(0); PG8_MMA(0, 0, At, B0); PG8_BAR; PG8_SCHED;
            PG8_LDB(B1, 0, 1); PG8_STAGE(PG8_SB(0, 0), b2, voffB);
            PG8_BAR; PG8_WAIT_L(0); PG8_MMA(0, 1, At, B1); PG8_BAR;
            PG8_LDA(At, 0, 1); PG8_STAGE(PG8_SA(0, 0), a2, voffA);
            PG8_BAR; PG8_WAIT_L(0); PG8_MMA(1, 0, At, B0); PG8_BAR; PG8_SCHED;
            PG8_STAGE(PG8_SB(0, 1), b2 + bstep, voffB);
            PG8_WAIT_V(6); PG8_BAR; PG8_MMA(1, 1, At, B1); PG8_BAR;
            PG8_LDB(B0, 1, 0); PG8_SCHED; PG8_LDA(At, 1, 0); PG8_STAGE(PG8_SA(0, 1), a2 + hstep, voffA);
            PG8_WAIT_L(8); PG8_BAR; PG8_WAIT_L(0); PG8_MMA(0, 0, At, B0); PG8_BAR; PG8_SCHED;
            PG8_LDB(B1, 1, 1); PG8_STAGE(PG8_SB(1, 0), b3, voffB);
            PG8_BAR; PG8_WAIT_L(0); PG8_MMA(0, 1, At, B1); PG8_BAR;
            PG8_LDA(At, 1, 1); PG8_STAGE(PG8_SA(1, 0), a3, voffA);
            PG8_BAR; PG8_WAIT_L(0); PG8_MMA(1, 0, At, B0); PG8_BAR; PG8_SCHED;
            PG8_STAGE(PG8_SB(1, 1), b3 + bstep, voffB);
            PG8_WAIT_V(6); PG8_BAR; PG8_MMA(1, 1, At, B1); PG8_BAR;
            }
        }
        if constexpr (ALIGN_EPI) { if (wr == 0) PG8_BAR; }
        if constexpr (!Epi::AFTER_DRAIN) { E(acc, cur, wr, wc, fr, fq); S.done(cur); }
        if (!has_next) break;
#pragma unroll
        for (int a = 0; a < 2; ++a)
#pragma unroll
            for (int b = 0; b < 2; ++b)
#pragma unroll
                for (int m = 0; m < 4; ++m)
#pragma unroll
                    for (int n = 0; n < 2; ++n) acc[a][b][m][n] = (f32x4){0.f, 0.f, 0.f, 0.f};
        cur = nxt; cA = nA; cB = nB; ++ui;
        PG8_LANE_OFFS();
        if constexpr (ALIGN_EPI) { if (wr == 1) PG8_BAR; }
    }
    PG8_WAIT_V(0);
    if constexpr (!ALIGN_EPI) { if (wr == 0) PG8_BAR; }
    PG8_BAR;
    if constexpr (Epi::AFTER_DRAIN) { E.fused(acc, cur, wr, wc, fr, fq, lds, wid, lane); S.done(cur); }
#undef PG8_LANE_OFFS
#undef PG8_SA
#undef PG8_SB
#undef PG8_STAGE
#undef PG8_LDA
#undef PG8_LDB
#undef PG8_MMA
#undef PG8_WAIT_V
#undef PG8_WAIT_L
#undef PG8_BAR
#undef PG8_SCHED
}
}

constexpr size_t MiB = 1u << 20;
constexpr size_t WS_CTL = 0, CTL_ZERO_BYTES = 65536;
constexpr size_t WS_WIN = 1 * MiB;
constexpr size_t WS_WOUT = 17 * MiB;
constexpr size_t WS_MOD = 21 * MiB;
constexpr size_t WS_ROPE = 22 * MiB;
constexpr size_t WS_KM = 24 * MiB;
constexpr size_t WS_LSE = 25 * MiB;
constexpr size_t WS_QKV = 32 * MiB;
constexpr size_t WS_Y = 32 * MiB;
constexpr size_t WS_OP = 288 * MiB;
constexpr size_t WS_H = 288 * MiB;
constexpr size_t WS_MIX = 384 * MiB;
constexpr size_t WS_X1B = 448 * MiB;
constexpr size_t WS_END = 512 * MiB;
constexpr int CW_RANK = 8192;
constexpr int CW_BAR = 4096;

#ifndef REP_P3A
#define REP_P3A 1
#endif
#ifndef REP_P3B
#define REP_P3B 1
#endif
#ifndef REP_P2
#define REP_P2 1
#endif
#ifndef REP_P4
#define REP_P4 1
#endif
#ifndef REP_P5
#define REP_P5 1
#endif
#ifndef REP_P0
#define REP_P0 1
#endif
#ifndef REP_P1
#define REP_P1 1
#endif
#ifndef REP_MOBA
#define REP_MOBA 1
#endif
constexpr int NWAVES = 8;
constexpr int RING_BYTES = 139264, LDSCTL_OFF = RING_BYTES, MISC_OFF = LDSCTL_OFF + 320, EPI_OFF = MISC_OFF + 192, LDS_BYTES = EPI_OFF + 8 * 16 * 144;

#define GAS __attribute__((address_space(1)))
#define LAS __attribute__((address_space(3)))
typedef unsigned short bf16;
typedef unsigned v4u __attribute__((ext_vector_type(4)));
typedef unsigned v2u __attribute__((ext_vector_type(2)));
typedef float f32x4 __attribute__((ext_vector_type(4)));
typedef float f32x16 __attribute__((ext_vector_type(16)));
typedef short bf16x8 __attribute__((ext_vector_type(8)));
typedef short s16x4 __attribute__((ext_vector_type(4)));
typedef GAS unsigned gu32;
#define LDS_WAIT() asm volatile("s_waitcnt lgkmcnt(0)" ::: "memory")
#define VM_WAIT() asm volatile("s_waitcnt vmcnt(0)" ::: "memory")
__device__ __forceinline__ unsigned f2bf(float f) { unsigned u = __builtin_bit_cast(unsigned, f); return (u + 0x7fffu + ((u >> 16) & 1u)) >> 16; }
typedef float f32x2_g __attribute__((ext_vector_type(2))); typedef __bf16 bf16x2_g __attribute__((ext_vector_type(2)));
__device__ __forceinline__ unsigned pk2(float lo, float hi) { f32x2_g v = {lo, hi}; bf16x2_g b = __builtin_convertvector(v, bf16x2_g); return __builtin_bit_cast(unsigned, b); }
__device__ __forceinline__ float bflo(unsigned w) { return __builtin_bit_cast(float, w << 16); }
__device__ __forceinline__ float bfhi(unsigned w) { return __builtin_bit_cast(float, w & 0xffff0000u); }

#define XB_TMO      128
#define XB_XCNT(j)  (256  + 64 * (j))
#define XB_XSUB(j)  (1280 + 64 * (j))
#define XB_XGEN(j)  (2304 + 64 * (j))
#define XB_TOP      3328
#define XB_TOPGEN   3392
#define XCD_BAR_WORDS 3456
#define XB_SPIN_CAP (1u << 18)

__device__ __forceinline__ unsigned xb_ld(unsigned* p)              { return __hip_atomic_load(p, __ATOMIC_RELAXED, __HIP_MEMORY_SCOPE_AGENT); }
__device__ __forceinline__ unsigned xb_add(unsigned* p, unsigned v) { return __hip_atomic_fetch_add(p, v, __ATOMIC_RELAXED, __HIP_MEMORY_SCOPE_AGENT); }
__device__ __forceinline__ unsigned xb_xcc_id() { return (unsigned)__builtin_amdgcn_s_getreg((3 << 11) | 20) & 0xFu; }
#define XB_SPIN(cond, bar) do { unsigned _sp = 0; while (cond) { __builtin_amdgcn_s_sleep(1); \
    if ((++_sp & 255u) == 0u) { if (xb_ld(&(bar)[XB_TMO])) break; if (_sp > XB_SPIN_CAP) { atomicAdd(&(bar)[XB_TMO], 1u); break; } } } } while (0)

struct XcdBarrier {
    unsigned* bar; unsigned x;
    volatile LAS unsigned* st;
};

__device__ __forceinline__ XcdBarrier xcd_barrier_post(unsigned* bar, volatile LAS unsigned* st) {
    XcdBarrier b; b.bar = bar; b.x = xb_xcc_id(); b.st = st;
    if (threadIdx.x == 0) (void)xb_add(&bar[XB_XCNT(b.x)], 1u);
    return b;
}
__device__ __forceinline__ void xcd_barrier_complete(unsigned* bar, unsigned x, unsigned& nloc, unsigned& nx) {
    const unsigned G = gridDim.x * gridDim.y * gridDim.z;
    unsigned sum, cnt, mine, sp = 0u;
    for (;;) {
        sum = 0u; cnt = 0u; mine = 0u;
#pragma unroll
        for (unsigned j = 0; j < 16; ++j) { const unsigned c = xb_ld(&bar[XB_XCNT(j)]); sum += c; cnt += (c > 0u) ? 1u : 0u; mine = (j == x) ? c : mine; }
        if (sum == G) break;
        __builtin_amdgcn_s_sleep(1);
        if ((++sp & 255u) == 0u) { if (xb_ld(&bar[XB_TMO])) break; if (sp > XB_SPIN_CAP) { atomicAdd(&bar[XB_TMO], 1u); break; } }
    }
    nloc = mine > 0u ? mine : 1u; nx = cnt > 0u ? cnt : 1u;
}

__device__ __forceinline__ void xcd_barrier(const XcdBarrier& b) {
    asm volatile("s_waitcnt vmcnt(0)" ::: "memory");
    __syncthreads();
    if (threadIdx.x == 0) {
        unsigned* bar = b.bar;
        __builtin_amdgcn_s_waitcnt(0);
        unsigned nloc = b.st[0], nx = b.st[1];
        if (nloc == 0u) { xcd_barrier_complete(bar, b.x, nloc, nx); b.st[0] = nloc; b.st[1] = nx; }
        const unsigned old = xb_add(&bar[XB_XSUB(b.x)], 1u);
        const unsigned gen = old / nloc;
        if (old + 1u == (gen + 1u) * nloc) {
            __builtin_amdgcn_fence(__ATOMIC_RELEASE, "agent");
            asm volatile("s_waitcnt vmcnt(0)" ::: "memory");
            const unsigned og = xb_add(&bar[XB_TOP], 1u);
            const unsigned tg = og / nx;
            if (og + 1u == (tg + 1u) * nx) xb_add(&bar[XB_TOPGEN], 1u);
            else XB_SPIN(xb_ld(&bar[XB_TOPGEN]) == tg, bar);
            __builtin_amdgcn_fence(__ATOMIC_ACQUIRE, "agent");
            xb_add(&bar[XB_XGEN(b.x)], 1u);
            asm volatile("s_waitcnt vmcnt(0)" ::: "memory");
        } else {
            XB_SPIN(xb_ld(&bar[XB_XGEN(b.x)]) == gen, bar);
            __builtin_amdgcn_fence(__ATOMIC_ACQUIRE, "agent");
            asm volatile("s_waitcnt vmcnt(0)" ::: "memory");
        }
    }
    __syncthreads();
}


__device__ __forceinline__ float wave_sum(float v) {
#pragma unroll
    for (int o = 1; o < 64; o <<= 1) v += __shfl_xor(v, o);
    return v;
}
__device__ __forceinline__ void p0_transpose_item(const float* W, int K, int N, bf16* WT, int row_off, LAS float* scr, int item, int lane) {
    const int nblk = N / 32, kb = item / nblk, nb = item % nblk, k0 = 64 * kb, n0 = 32 * nb;
#pragma unroll 8
    for (int i = 0; i < 32; ++i) { const int kk = 2 * i + (lane >> 5); scr[kk * 33 + (lane & 31)] = __builtin_nontemporal_load(W + (size_t)(k0 + kk) * N + n0 + (lane & 31)); }
    LDS_WAIT(); asm volatile("" ::: "memory");
    const int c = lane & 7;
#pragma unroll
    for (int j = 0; j < 4; ++j) { const int n = (lane >> 3) + 8 * j; const LAS float* s = scr + (8 * c) * 33 + n;
        v4u o; o.x = pk2(s[0 * 33], s[1 * 33]); o.y = pk2(s[2 * 33], s[3 * 33]); o.z = pk2(s[4 * 33], s[5 * 33]); o.w = pk2(s[6 * 33], s[7 * 33]);
        *(GAS v4u*)(WT + (size_t)(row_off + n0 + n) * K + k0 + 8 * c) = o; }
    LDS_WAIT(); asm volatile("" ::: "memory");
}


namespace att3 {
constexpr int K_OFF = 0, V_OFF = 49152, WQ_OFF = 98304, WQ_B = 4608, WSC_OFF = WQ_OFF + 8 * WQ_B;
static_assert(WSC_OFF + 8 * 512 <= LDSCTL_OFF, "attention LDS map below the control words");
__device__ __forceinline__ int crow(int r, int hi) { return (r & 3) + 8 * (r >> 2) + 4 * hi; }
__device__ __forceinline__ void glds16(const void* gsrc, unsigned lds_dst) { unsigned keep;
    asm volatile("s_mov_b32 %0, m0\n\ts_mov_b32 m0, %2\n\ts_nop 0\n\tglobal_load_lds_dwordx4 %1, off\n\ts_mov_b32 m0, %0" : "=&s"(keep) : "v"(gsrc), "s"(lds_dst) : "memory"); }
__device__ __forceinline__ void glds16nt(const void* gsrc, unsigned lds_dst) { unsigned keep;
    asm volatile("s_mov_b32 %0, m0\n\ts_mov_b32 m0, %2\n\ts_nop 0\n\tglobal_load_lds_dwordx4 %1, off nt\n\ts_mov_b32 m0, %0" : "=&s"(keep) : "v"(gsrc), "s"(lds_dst) : "memory"); }
typedef float f32x2_t __attribute__((ext_vector_type(2))); typedef __bf16 bf16x2_t __attribute__((ext_vector_type(2)));
__device__ __forceinline__ unsigned cvtpk(float lo, float hi) { f32x2_t v = {lo, hi}; bf16x2_t b = __builtin_convertvector(v, bf16x2_t); return __builtin_bit_cast(unsigned, b); }
typedef short v4i16_t __attribute__((ext_vector_type(4)));
typedef LAS const char* lds_cptr;
__device__ __forceinline__ s16x4 vtr(lds_cptr p) { return __builtin_bit_cast(s16x4, __builtin_amdgcn_ds_read_tr16_b64_v4i16((LAS v4i16_t*)p)); }
__device__ __forceinline__ float xhalf_max(float v) { auto rr = __builtin_amdgcn_permlane32_swap(__float_as_uint(v), __float_as_uint(v), false, false); return fmaxf(__uint_as_float(rr[0]), __uint_as_float(rr[1])); }
__device__ __forceinline__ float xhalf_sum(float v) { auto rr = __builtin_amdgcn_permlane32_swap(__float_as_uint(v), __float_as_uint(v), false, false); return __uint_as_float(rr[0]) + __uint_as_float(rr[1]); }
#define MFMA32(a, b, c) __builtin_amdgcn_mfma_f32_32x32x16_bf16(a, b, c, 0, 0, 0)
#define BAR() asm volatile("s_waitcnt lgkmcnt(0)\n\ts_barrier" ::: "memory")
#define WAITV_BAR(N) asm volatile("s_waitcnt vmcnt(" #N ") lgkmcnt(0)\n\ts_barrier" ::: "memory")

struct UnitA { int bh, dl, r0, m0u, two, tnew, nnew; };
__device__ __forceinline__ UnitA make_unit(int bh, int u) {
    UnitA U; U.bh = bh;
    if (u < 8) { U.dl = 0; U.r0 = 0; U.m0u = 256 * u; U.two = 0; }
    else if (u < 16) { U.dl = 2; U.r0 = (u - 8) >> 1; U.m0u = 256 * ((u - 8) & 1); U.two = 0; }
    else { U.dl = 4; U.r0 = 2 * (u - 16); U.m0u = 0; U.two = 1; }
    const int kstart = (!U.two && U.m0u >= 128) ? U.m0u - 128 : 0;
    U.tnew = kstart >> 6; U.nnew = U.two ? 4 : (U.m0u + 256 - kstart) / 64;
    return U;
}
__device__ __forceinline__ UnitA make_chain_unit(int bh, int dil4, int n) {
    UnitA U; U.bh = bh; U.two = 0;
    if (!dil4) { U.dl = 0; U.r0 = 0; U.m0u = 256 * n; U.tnew = (n == 0) ? 0 : 4 * n; U.nnew = 4; }
    else { U.dl = 2; U.r0 = n >> 1; U.m0u = 256 * (n & 1); U.tnew = (n & 1) ? 4 : 0; U.nnew = 4; }
    return U;
}
__device__ __forceinline__ int tile_tok0(const UnitA& U, int t) { return U.two ? ((64 * (t & 1)) << U.dl) + U.r0 + (t >> 1) : ((64 * t) << U.dl) + U.r0; }
__device__ __forceinline__ int slot_of(int t) { return t % 6; }
__device__ __forceinline__ void dma_k(const UnitA& U, const bf16* KA, unsigned lds0, int wid, int lane) {
    const bf16* Kh = KA + (size_t)U.bh * SEQ * 64; const int st = 1 << U.dl;
    const int krow = 8 * wid + (lane >> 3), kch = (lane & 7) ^ ((krow >> 1) & 7);
    for (int i = 0; i < U.nnew; ++i) { const int t = U.tnew + i; glds16(Kh + (size_t)(tile_tok0(U, t) + krow * st) * 64 + kch * 8, (unsigned)__builtin_amdgcn_readfirstlane(lds0 + K_OFF + slot_of(t) * 8192 + wid * 1024)); }
}
__device__ __forceinline__ void dma_v(const UnitA& U, const bf16* VA, unsigned lds0, int wid, int lane) {
    const bf16* Vh = VA + (size_t)U.bh * SEQ * 64; const int st = 1 << U.dl;
    for (int i = 0; i < U.nnew; ++i) { const int t = U.tnew + i; glds16(Vh + (size_t)(tile_tok0(U, t) + (16 * (wid & 3) + (lane >> 2)) * st) * 64 + (wid >> 2) * 32 + (lane & 3) * 8, (unsigned)__builtin_amdgcn_readfirstlane(lds0 + V_OFF + slot_of(t) * 8192 + wid * 1024)); }
}
__device__ __forceinline__ void wave_geom(const UnitA& U, int wid, int& cls, int& mq0) { cls = U.two ? (wid >> 2) : 0; mq0 = U.two ? 32 * (wid & 3) : U.m0u + 32 * wid; }
__device__ __forceinline__ void dma_q(const UnitA& U, const bf16* QA, unsigned lds0, int wid, int lane) {
    int cls, mq0; wave_geom(U, wid, cls, mq0);
#pragma unroll
    for (int i = 0; i < 4; ++i) { const int row = 8 * i + (lane >> 3), ch = (lane & 7) ^ ((row >> 1) & 7);
        glds16nt(QA + ((size_t)U.bh * SEQ + (((mq0 + row) << U.dl) + U.r0 + cls)) * 64 + ch * 8, (unsigned)__builtin_amdgcn_readfirstlane(lds0 + WQ_OFF + wid * WQ_B + i * 1024)); }
}

template <bool FINAL, class UnitFn>
__device__ __forceinline__ void run_units(int n_units, UnitFn unit_of, const bf16* QA, const bf16* KA, const bf16* VA, const bf16* GA, bf16* OP, float* LSE, bf16* MIX, LAS char* lds) {
    int tid_o = threadIdx.x; asm volatile("" : "+v"(tid_o));
    const int lane = tid_o & 63, wid = __builtin_amdgcn_readfirstlane(tid_o >> 6);
    const int r32 = lane & 31, hi = lane >> 5;
    const unsigned lds0 = (unsigned)(size_t)lds;
    UnitA U = unit_of(0);
    dma_q(U, QA, lds0, wid, lane); dma_k(U, KA, lds0, wid, lane); dma_v(U, VA, lds0, wid, lane);
    for (int n = 0; n < n_units; ++n) {
        const bool has_next = n + 1 < n_units;
        UnitA UN = U; if (has_next) UN = unit_of(n + 1);
        int cls, mq0; wave_geom(U, wid, cls, mq0);
        if (U.nnew == 6) WAITV_BAR(6); else WAITV_BAR(4);
        const lds_cptr wq = (lds_cptr)lds + WQ_OFF + wid * WQ_B;
        bf16x8 qr[4];
#pragma unroll
        for (int d0 = 0; d0 < 4; ++d0) qr[d0] = *(const LAS bf16x8*)(wq + r32 * 128 + (((2 * d0 + hi) ^ ((r32 >> 1) & 7)) << 4));
        const int gg0 = U.two ? 4 * cls + (mq0 >> 5) : (mq0 >> 5);
        const int ng = (mq0 >> 5) < 4 ? (mq0 >> 5) + 1 : 5;
        f32x16 S[5];
#pragma unroll
        for (int g = 0; g < 5; ++g) {
            f32x16 acc; float ini = (g < ng) ? 0.f : -INFINITY; asm volatile("" : "+v"(ini));
#pragma unroll
            for (int r = 0; r < 16; ++r) acc[r] = ini;
            asm volatile("" : "+v"(acc));
            {
                const int gg = (g < ng) ? gg0 - g : gg0;
                const lds_cptr kp = (lds_cptr)lds + K_OFF + slot_of(gg >> 1) * 8192 + ((gg & 1) * 32 + r32) * 128;
#pragma unroll
                for (int d0 = 0; d0 < 4; ++d0) acc = MFMA32(*(const LAS bf16x8*)(kp + (((2 * d0 + hi) ^ ((r32 >> 1) & 7)) << 4)), qr[d0], acc);
            }
            S[g] = acc;
        }
        const float NINF = -INFINITY;
#pragma unroll
        for (int r = 0; r < 16; ++r) { if (crow(r, hi) > r32) S[0][r] = NINF; }
#pragma unroll
        for (int r = 0; r < 16; ++r) { if (crow(r, hi) < r32) S[4][r] = NINF; }
        BAR();
        const int dl = U.dl, rc = U.r0 + cls, bh = U.bh;
        const int qtok = ((mq0 + r32) << dl) + rc;
        float la = 0.f, lb = 0.f; v4u a0[4], a1[4], gq[4];
        if (FINAL) {
            const size_t q = (size_t)bh * SEQ + qtok;
            la = LSE[q]; lb = LSE[(size_t)128 * SEQ + q];
#pragma unroll
            for (int i = 0; i < 4; ++i) { const int row = i * 8 + (lane >> 3), ch = lane & 7;
                const size_t qq = (size_t)bh * SEQ + (((mq0 + row) << dl) + rc);
                a0[i] = __builtin_nontemporal_load((const v4u*)(OP + qq * 64 + ch * 8)); a1[i] = __builtin_nontemporal_load((const v4u*)(OP + ((size_t)128 * SEQ + qq) * 64 + ch * 8)); gq[i] = __builtin_nontemporal_load((const v4u*)(GA + qq * 64 + ch * 8)); }
        }
        if (has_next) { dma_k(UN, KA, lds0, wid, lane); dma_q(UN, QA, lds0, wid, lane); }
        float rm = S[0][0];
#pragma unroll
        for (int r = 1; r < 16; ++r) rm = fmaxf(rm, S[0][r]);
#pragma unroll
        for (int g = 1; g < 5; ++g) {
#pragma unroll
            for (int r = 0; r < 16; ++r) rm = fmaxf(rm, S[g][r]); }
        const float m = xhalf_max(rm);
        float l0 = 0.f, l1 = 0.f;
        v4u P[5][2];
#pragma unroll
        for (int g = 0; g < 5; ++g) {
#pragma unroll
            for (int r = 0; r < 16; ++r) S[g][r] = __builtin_amdgcn_exp2f(S[g][r] - m);
#pragma unroll
            for (int r = 0; r < 16; r += 2) { l0 += S[g][r]; l1 += S[g][r + 1]; }
            P[g][0].x = cvtpk(S[g][0], S[g][1]); P[g][0].y = cvtpk(S[g][2], S[g][3]); P[g][0].z = cvtpk(S[g][4], S[g][5]); P[g][0].w = cvtpk(S[g][6], S[g][7]);
            P[g][1].x = cvtpk(S[g][8], S[g][9]); P[g][1].y = cvtpk(S[g][10], S[g][11]); P[g][1].z = cvtpk(S[g][12], S[g][13]); P[g][1].w = cvtpk(S[g][14], S[g][15]);
        }
        if (!has_next) WAITV_BAR(0); else if (UN.nnew == 6) WAITV_BAR(10); else WAITV_BAR(8);
        f32x16 o0, o1; { float zf = 0.f; asm volatile("" : "+v"(zf));
#pragma unroll
          for (int r = 0; r < 16; ++r) { o0[r] = zf; o1[r] = zf; } } asm volatile("" : "+v"(o0), "+v"(o1));
#pragma unroll
        for (int g = 0; g < 5; ++g) {
            const int gg = (g < ng) ? gg0 - g : gg0;
            const lds_cptr vp = (lds_cptr)lds + V_OFF + slot_of(gg >> 1) * 8192 + (2 * (gg & 1)) * 1024 + ((lane >> 4) & 1) * 32 + (lane & 3) * 8 + (4 * hi + ((lane & 15) >> 2)) * 64;
#define VF(off) ({ const s16x4 lo_ = vtr(vp + (off)); const s16x4 hi_ = vtr(vp + (off) + 512); (bf16x8){lo_[0], lo_[1], lo_[2], lo_[3], hi_[0], hi_[1], hi_[2], hi_[3]}; })
            const bf16x8 pf0 = __builtin_bit_cast(bf16x8, P[g][0]), pf1 = __builtin_bit_cast(bf16x8, P[g][1]);
            o0 = MFMA32(VF(0), pf0, o0); o1 = MFMA32(VF(4096), pf0, o1);
            o0 = MFMA32(VF(1024), pf1, o0); o1 = MFMA32(VF(4096 + 1024), pf1, o1);
#undef VF
        }
        BAR();
        const float lt = xhalf_sum(l0 + l1), inv = 1.f / lt;
        const float lse = m + __builtin_amdgcn_logf(lt);
        if (!FINAL) {
            const size_t pb = (size_t)((dl >> 1) * 128 + bh) * SEQ;
            if (hi == 0) LSE[pb + qtok] = lse;
            LAS char* stg = lds + V_OFF + wid * WQ_B;
#pragma unroll
            for (int dh = 0; dh < 2; ++dh)
#pragma unroll
                for (int rq = 0; rq < 4; ++rq) { const f32x16& o = dh ? o1 : o0;
                    v2u w; w.x = cvtpk(o[4 * rq] * inv, o[4 * rq + 1] * inv); w.y = cvtpk(o[4 * rq + 2] * inv, o[4 * rq + 3] * inv);
                    *(LAS v2u*)(stg + r32 * 144 + (32 * dh + 8 * rq + 4 * hi) * 2) = w; }
#pragma unroll
            for (int i = 0; i < 4; ++i) { const int row = i * 8 + (lane >> 3), ch = lane & 7;
                const v4u v = *(const LAS v4u*)(stg + row * 144 + ch * 16);
                __builtin_nontemporal_store(v, (v4u*)(OP + (pb + ((mq0 + row) << dl) + rc) * 64 + ch * 8)); }
            BAR();
            if (has_next) dma_v(UN, VA, lds0, wid, lane);
        } else {
            LAS char* stg = lds + V_OFF + wid * WQ_B;
#pragma unroll
            for (int dh = 0; dh < 2; ++dh)
#pragma unroll
                for (int rq = 0; rq < 4; ++rq) { const f32x16& o = dh ? o1 : o0;
                    v2u w; w.x = cvtpk(o[4 * rq] * inv, o[4 * rq + 1] * inv); w.y = cvtpk(o[4 * rq + 2] * inv, o[4 * rq + 3] * inv);
                    *(LAS v2u*)(stg + r32 * 144 + (32 * dh + 8 * rq + 4 * hi) * 2) = w; }
            LAS float* wsc = (LAS float*)(lds + WSC_OFF) + wid * 128;
            const float mx = fmaxf(lse, fmaxf(la, lb));
            const float w0 = __builtin_amdgcn_exp2f(la - mx), w1 = __builtin_amdgcn_exp2f(lb - mx), w2 = __builtin_amdgcn_exp2f(lse - mx);
            const float winv = 1.f / (w0 + w1 + w2);
            if (hi == 0) { wsc[r32 * 4 + 0] = w0 * winv; wsc[r32 * 4 + 1] = w1 * winv; wsc[r32 * 4 + 2] = w2 * winv; }
            const int b = bh >> 3, h = bh & 7;
#pragma unroll
            for (int i = 0; i < 4; ++i) { const int row = i * 8 + (lane >> 3), ch = lane & 7;
                const int tok = ((mq0 + row) << dl) + rc;
                const v4u a2 = *(const LAS v4u*)(stg + row * 144 + ch * 16);
                const float x0 = wsc[row * 4 + 0], x1 = wsc[row * 4 + 1], x2 = wsc[row * 4 + 2];
                v4u o;
#define MRG(c) pk2((x0 * bflo(a0[i].c) + x1 * bflo(a1[i].c) + x2 * bflo(a2.c)) * bflo(gq[i].c), (x0 * bfhi(a0[i].c) + x1 * bfhi(a1[i].c) + x2 * bfhi(a2.c)) * bfhi(gq[i].c))
                o.x = MRG(x); o.y = MRG(y); o.z = MRG(z); o.w = MRG(w);
#undef MRG
                *(v4u*)(MIX + (size_t)(b * SEQ + tok) * DM + h * 64 + ch * 8) = o; }
            BAR();
            if (has_next) dma_v(UN, VA, lds0, wid, lane);
        }
        U = UN;
    }
    WAITV_BAR(0);
}
#undef MFMA32
#undef BAR
#undef WAITV_BAR
}

namespace attb {
using bf16=__hip_bfloat16;
using bf16x8=__attribute__((ext_vector_type(8)))short;
using s16x4=__attribute__((ext_vector_type(4)))short;
using f32x16=__attribute__((ext_vector_type(16)))float;
using u32x4=__attribute__((ext_vector_type(4)))unsigned;
typedef float f32x4g __attribute__((ext_vector_type(4)));
#define BFLO(w) __builtin_bit_cast(float,(unsigned)(w)<<16)
#define BFHI(w) __builtin_bit_cast(float,(unsigned)(w)&0xffff0000u)
constexpr int SEQ=2048,D=64,DM=64;
constexpr int NW=8,QBLK=32,QB=QBLK*NW,KVBLK=64,NQB=SEQ/QB;
__device__ __forceinline__ int crow(int r,int hi){return (r&3)+8*(r>>2)+4*hi;}
#define SBAR() __builtin_amdgcn_sched_barrier(0)
__device__ __forceinline__ void cmask(f32x16&p0,f32x16&p1,int jb,int qrel,int hi){
  const float NEG=-INFINITY; int kb=64*jb+4*hi;
  #pragma unroll
  for(int r=0;r<16;++r){int kv=kb+(r&3)+8*(r>>2); if(kv>qrel)p0[r]=NEG; if(kv+32>qrel)p1[r]=NEG;}
}

constexpr int NSLOT=3, SLOTB=8192;
constexpr int LDS_K=0, LDS_V=NSLOT*SLOTB, LDS_WS=2*NSLOT*SLOTB, LDS_OST=LDS_WS+NW*64*4, LDS_Q=LDS_OST+NW*4096, LDS_KM=LDS_Q+NW*4096, LDS_BYTES=LDS_KM+2048;
constexpr float C2=0.125f*1.4426950408889634f;
__device__ __forceinline__ void glds16(const void*gsrc,unsigned lds_dst){unsigned keep;
  asm volatile("s_mov_b32 %0, m0\n\ts_mov_b32 m0, %2\n\ts_nop 0\n\tglobal_load_lds_dwordx4 %1, off\n\ts_mov_b32 m0, %0":"=&s"(keep):"v"(gsrc),"s"(lds_dst):"memory");}
__device__ __forceinline__ void glds16nt(const void*gsrc,unsigned lds_dst){unsigned keep;
  asm volatile("s_mov_b32 %0, m0\n\ts_mov_b32 m0, %2\n\ts_nop 0\n\tglobal_load_lds_dwordx4 %1, off nt\n\ts_mov_b32 m0, %0":"=&s"(keep):"v"(gsrc),"s"(lds_dst):"memory");}
__device__ __forceinline__ float max3f(float a,float b,float c){float r;asm("v_max3_f32 %0, %1, %2, %3":"=v"(r):"v"(a),"v"(b),"v"(c));return r;}
__device__ __forceinline__ float max2f(float a,float b){float r;asm("v_max_f32_e32 %0, %1, %2":"=v"(r):"v"(a),"v"(b));return r;}
__device__ __forceinline__ float fadd_s(float a,float b){float r;asm("v_add_f32_e32 %0, %1, %2":"=v"(r):"v"(a),"v"(b));return r;}
__device__ __forceinline__ float fsub_s(float a,float b){float r;asm("v_sub_f32_e32 %0, %1, %2":"=v"(r):"v"(a),"v"(b));return r;}
typedef float f32x2_t __attribute__((ext_vector_type(2))); typedef __bf16 bf16x2_t __attribute__((ext_vector_type(2)));
__device__ __forceinline__ unsigned cvtpk_s(float lo,float hi){f32x2_t v={lo,hi};bf16x2_t b=__builtin_convertvector(v,bf16x2_t);return __builtin_bit_cast(unsigned,b);}
#define WAIT_BAR(N) asm volatile("s_waitcnt vmcnt(" #N ") lgkmcnt(0)\n\ts_barrier":::"memory")

__device__ __forceinline__ void qkt(f32x16&p0,f32x16&p1,const char*Kslot,const bf16x8*qr,const f32x16&negm,int r32,int hi){
  const char*kb=Kslot+hi*1024+r32*16;
  #pragma unroll
  for(int d0=0;d0<4;++d0){
    const bf16x8 b0=*reinterpret_cast<const bf16x8*>(kb+d0*2048);
    const bf16x8 b1=*reinterpret_cast<const bf16x8*>(kb+d0*2048+512);
    if(d0==0){p0=__builtin_amdgcn_mfma_f32_32x32x16_bf16(b0,qr[0],negm,0,0,0);p1=__builtin_amdgcn_mfma_f32_32x32x16_bf16(b1,qr[0],negm,0,0,0);}
    else{p0=__builtin_amdgcn_mfma_f32_32x32x16_bf16(b0,qr[d0],p0,0,0,0);p1=__builtin_amdgcn_mfma_f32_32x32x16_bf16(b1,qr[d0],p1,0,0,0);}}
}
typedef __attribute__((address_space(3))) const char* lds_cptr;
typedef short v4i16_t __attribute__((ext_vector_type(4)));
__device__ __forceinline__ void kload8(bf16x8*kf,lds_cptr kp){
  kf[0]=*(const __attribute__((address_space(3))) bf16x8*)(kp);      kf[1]=*(const __attribute__((address_space(3))) bf16x8*)(kp+512);
  kf[2]=*(const __attribute__((address_space(3))) bf16x8*)(kp+2048); kf[3]=*(const __attribute__((address_space(3))) bf16x8*)(kp+2560);
  kf[4]=*(const __attribute__((address_space(3))) bf16x8*)(kp+4096); kf[5]=*(const __attribute__((address_space(3))) bf16x8*)(kp+4608);
  kf[6]=*(const __attribute__((address_space(3))) bf16x8*)(kp+6144); kf[7]=*(const __attribute__((address_space(3))) bf16x8*)(kp+6656);
}
__device__ __forceinline__ void kload2(bf16x8*kf,lds_cptr kp,int j){ kf[2*j]=*(const __attribute__((address_space(3))) bf16x8*)(kp+j*2048); kf[2*j+1]=*(const __attribute__((address_space(3))) bf16x8*)(kp+j*2048+512); }
__device__ __forceinline__ s16x4 vtr(lds_cptr p){ return __builtin_bit_cast(s16x4,__builtin_amdgcn_ds_read_tr16_b64_v4i16((__attribute__((address_space(3))) v4i16_t*)p)); }
__device__ __forceinline__ float rowmax(const f32x16&p0,const f32x16&p1){
  float a=max3f(p0[0],p0[1],p1[0]),b=max3f(p0[2],p0[3],p1[1]);a=max3f(a,p1[2],p1[3]);
  #pragma unroll
  for(int r=4;r<16;r+=4){a=max3f(a,p0[r],p0[r+1]);b=max3f(b,p0[r+2],p0[r+3]);a=max3f(a,p1[r],p1[r+1]);b=max3f(b,p1[r+2],p1[r+3]);}
  const float m=max2f(a,b);
  auto rr=__builtin_amdgcn_permlane32_swap(__float_as_uint(m),__float_as_uint(m),false,false);
  return max2f(__uint_as_float(rr[0]),__uint_as_float(rr[1]));
}
__device__ __forceinline__ void pv(f32x16*o,int vb,bf16x8 pa0,bf16x8 pa1,bf16x8 pa2,bf16x8 pa3){
  #pragma unroll
  for(int d0=0;d0<2;++d0){s16x4 lo[4],hi[4];
    #pragma unroll
    for(int ks=0;ks<4;++ks){
      asm volatile("ds_read_b64_tr_b16 %0,%1 offset:%c2":"=&v"(lo[ks]):"v"(vb),"i"(d0*4096+ks*1024):"memory");
      asm volatile("ds_read_b64_tr_b16 %0,%1 offset:%c2":"=&v"(hi[ks]):"v"(vb),"i"(d0*4096+ks*1024+512):"memory");}
    asm volatile("s_waitcnt lgkmcnt(0)":::"memory");SBAR();
    #define PK(k) (bf16x8){lo[k][0],lo[k][1],lo[k][2],lo[k][3],hi[k][0],hi[k][1],hi[k][2],hi[k][3]}
    o[d0]=__builtin_amdgcn_mfma_f32_32x32x16_bf16(pa0,PK(0),o[d0],0,0,0);
    o[d0]=__builtin_amdgcn_mfma_f32_32x32x16_bf16(pa1,PK(1),o[d0],0,0,0);
    o[d0]=__builtin_amdgcn_mfma_f32_32x32x16_bf16(pa2,PK(2),o[d0],0,0,0);
    o[d0]=__builtin_amdgcn_mfma_f32_32x32x16_bf16(pa3,PK(3),o[d0],0,0,0);
    #undef PK
  }
}

#ifndef ATTN_STORE16
#define ATTN_STORE16(p,v) (*(u32x4*)(p)=(v))
#endif
template<int THRL> __device__ __forceinline__ void moba_unit(int bh,int j,const bf16*Q,const bf16*__restrict__ K,const bf16*__restrict__ V,const unsigned short*G,const float*KM,unsigned short*MIX,char*shm,bool pre,int nbh,int nj){
  int tid_o=threadIdx.x; asm volatile("":"+v"(tid_o)); const int tid=tid_o,lane=tid&63,r32=lane&31,hi=lane>>5; const int wid=__builtin_amdgcn_readfirstlane(tid>>6);
  const long rowbase=(long)bh*SEQ; const int q0=j*QB;
  const bf16*Qw=Q+(rowbase+q0+wid*QBLK)*DM;
  const bf16*Kh=K+rowbase*DM,*Vh=V+rowbase*DM;
  const unsigned lds0=(unsigned)(uintptr_t)shm;
  float*wsf=(float*)(shm+LDS_WS)+wid*64;
  const bf16*ksrc=Kh+(long)lane*DM+wid*8;
  const bf16*vsrc=Vh+(long)(16*(wid&3)+(lane>>2))*DM+(wid>>2)*32+(lane&3)*8;
  const unsigned kdst=lds0+LDS_K+wid*1024, vdst=lds0+LDS_V+wid*1024;
  #define TROW(t) ((t)<4 ? q0+KVBLK*(t) : KVBLK*((t)-4))
  #define DMA_K(t,slot) glds16(ksrc+(long)TROW(t)*DM,(unsigned)__builtin_amdgcn_readfirstlane(kdst+(slot)))
  #define DMA_V(t,slot) glds16(vsrc+(long)TROW(t)*DM,(unsigned)__builtin_amdgcn_readfirstlane(vdst+(slot)))
  const int vb0=(int)(lds0+LDS_V)+((lane>>4)&1)*32+(lane&3)*8+(4*hi+((lane&15)>>2))*64;
  const char*Kbase=shm+LDS_K; bf16x8 kf[8];
  const lds_cptr shm3=(lds_cptr)shm; const lds_cptr qlp=shm3+LDS_Q+wid*4096+(hi*32+r32)*16;
  #define QL(d0) (*(const __attribute__((address_space(3))) bf16x8*)(qlp+(d0)*1024))
  const lds_cptr kp0=shm3+LDS_K+hi*1024+r32*16; const lds_cptr vp0=shm3+LDS_V+((lane>>4)&1)*32+(lane&3)*8+(4*hi+((lane&15)>>2))*64;
  const int NT=4+4*j;
  { const bf16*qsrc=Qw+(long)(lane&31)*DM+(lane>>5)*8; const unsigned qdst=lds0+LDS_Q+wid*4096;
    if(!pre){ _Pragma("unroll") for(int i=0;i<4;++i) glds16nt(qsrc+i*16,(unsigned)__builtin_amdgcn_readfirstlane(qdst+i*1024)); }
    const unsigned short*gsrc=G+(rowbase+q0+wid*QBLK+(lane>>3))*DM+(lane&7)*8; const unsigned gdst=lds0+LDS_OST+wid*4096;
    _Pragma("unroll") for(int i=0;i<4;++i) glds16nt(gsrc+(long)i*8*DM,(unsigned)__builtin_amdgcn_readfirstlane(gdst+i*1024));
    if(!pre&&wid<2) glds16(KM+(size_t)bh*512+wid*256+lane*4,(unsigned)__builtin_amdgcn_readfirstlane(lds0+LDS_KM+wid*1024)); }
  if(!pre){DMA_K(0,0);} DMA_V(0,0); if(!pre){DMA_K(1,SLOTB);}
  float mhat=0.f,l_reg=0.f,msk=0.f;f32x16 o[2];{ float zf_=0.f; asm volatile("":"+v"(zf_)); _Pragma("unroll") for(int r=0;r<16;++r){o[0][r]=zf_;o[1][r]=zf_;} } asm volatile("":"+v"(o[0]),"+v"(o[1]));    float nmv=0.f;
  const int qrel=wid*QBLK+r32;
  #define CMASK(P0,P1,t) do{ if((t)<4) cmask(P0,P1,(t),qrel,hi); }while(0)
  bool resc=false;
  #define START(P0,P1) do{ const float rm=rowmax(P0,P1); resc=false; \
    { const float dl=rm; mhat=fadd_s(mhat,dl); \
      _Pragma("unroll") for(int r=0;r<16;++r){P0[r]=fsub_s(P0[r],dl);P1[r]=fsub_s(P1[r],dl);} \
      nmv=-mhat; } \
    _Pragma("unroll") for(int r=0;r<16;++r)P0[r]=__builtin_amdgcn_exp2f(P0[r]); }while(0)
  #define RESC() do{ if(resc){ asm volatile("s_waitcnt lgkmcnt(0)":::"memory"); \
      _Pragma("unroll") for(int d_=0;d_<2;++d_) _Pragma("unroll") for(int r=0;r<16;++r)o[d_][r]*=wsf[crow(r,hi)]; } }while(0)
  f32x16 pA0,pA1,pB0,pB1;
  int sl_prev=0,sl_cur=0,sl_next=SLOTB;
  #define ROT() do{sl_prev=sl_cur;sl_cur=sl_next;sl_next=(sl_next==(NSLOT-1)*SLOTB)?0:sl_next+SLOTB;}while(0)
  if(!pre){ DMA_K(2,2*SLOTB);
    WAIT_BAR(3); }
  else { WAIT_BAR(9); }
  bf16x8 ql_[4]; _Pragma("unroll") for(int d0=0;d0<4;++d0)ql_[d0]=QL(d0);
  unsigned sel=0u;
  if(j<=3) sel=(1u<<j)-1u;
  else{
    float g[7];
    const __attribute__((address_space(3))) float*kmb=(const __attribute__((address_space(3))) float*)(shm3+LDS_KM)+hi*8;
    #pragma unroll
    for(int n=0;n<7;++n){ float acc=0.f;
      if(n<j){
        #pragma unroll
        for(int d0=0;d0<4;++d0){ const f32x4g k0=*(const __attribute__((address_space(3))) f32x4g*)(kmb+n*64+d0*16),k1=*(const __attribute__((address_space(3))) f32x4g*)(kmb+n*64+d0*16+4);
          const u32x4 qw=__builtin_bit_cast(u32x4,ql_[d0]);
          acc+=BFLO(qw.x)*k0[0]+BFHI(qw.x)*k0[1]+BFLO(qw.y)*k0[2]+BFHI(qw.y)*k0[3]+BFLO(qw.z)*k1[0]+BFHI(qw.z)*k1[1]+BFLO(qw.w)*k1[2]+BFHI(qw.w)*k1[3]; }
        { auto rr=__builtin_amdgcn_permlane32_swap(__float_as_uint(acc),__float_as_uint(acc),false,false); acc=__uint_as_float(rr[0])+__uint_as_float(rr[1]); }
      }
      g[n]=acc; }
    #pragma unroll
    for(int t_=0;t_<3;++t_){ float best=0.f; int bi=-1;
      #pragma unroll
      for(int n=0;n<7;++n){ const bool cand=(n<j)&&!((sel>>n)&1u)&&(bi<0||g[n]>best); if(cand){best=g[n];bi=n;} }
      sel|=1u<<bi; }
  }
  bf16x8 q0p;
  { f32x16 z0_; { float zf_=0.f; asm volatile("":"+v"(zf_)); _Pragma("unroll") for(int r=0;r<16;++r)z0_[r]=zf_; } asm volatile("":"+v"(z0_)); q0p=ql_[0]; qkt(pA0,pA1,Kbase,ql_,z0_,r32,hi); }asm volatile("s_nop 15\n\ts_nop 7":"+v"(pA0),"+v"(pA1));CMASK(pA0,pA1,0);
  START(pA0,pA1);
  _Pragma("unroll") for(int r=0;r<16;++r)pA1[r]=__builtin_amdgcn_exp2f(pA1[r]);
  WAIT_BAR(0);
  DMA_K(3,0);DMA_V(1,SLOTB);
  ROT();
  kload8(kf,kp0+sl_cur);
  WAIT_BAR(2);
  s16x4 vlo[8],vhi[8]; u32x4 pw0,pw1,pw2,pw3;
  #define PKW(P,B) cvtpk_s(P[B],P[B+1])
  #define PAF(k) __builtin_bit_cast(bf16x8,pw##k)
  #define VFR(i) (bf16x8){vlo[i][0],vlo[i][1],vlo[i][2],vlo[i][3],vhi[i][0],vhi[i][1],vhi[i][2],vhi[i][3]}
  #define PIN(x) asm volatile("":"+v"(x))
  #define MX3(a,b,c) __builtin_fmaxf(__builtin_fmaxf((a),(b)),(c))
  #define GAPA(MF,A0,A1,A2,A3,W0,W1,PW) do{ MF; sacc+=A0; sacc+=A1; sacc+=A2; sacc+=A3; PIN(sacc); W0; W1; PIN(PW); SBAR(); }while(0)
  #define EX(v) __builtin_amdgcn_exp2f(v)
  #define GAPB(MF,X,B) do{ MF; X[B]=EX(X[B]); X[B+1]=EX(X[B+1]); X[B+2]=EX(X[B+2]); X[B+3]=EX(X[B+3]); PIN(X); SBAR(); }while(0)
  #define VRD(i) do{ vlo[i]=vtr(vp_+(((i)>>2)*4096+((i)&3)*1024)); vhi[i]=vtr(vp_+(((i)>>2)*4096+((i)&3)*1024+512)); }while(0)
  #define KRD(G,j) do{ if(G){ kload2(kf,kp0+sl_next,j); SBAR(); } }while(0)
  #define STEP(C0,C1,P0,P1,t,GK,GV,GL) do{ SBAR(); \
    const lds_cptr vp_=vp0+sl_prev; \
    VRD(0); SBAR(); float sacc=(P0[0]+P0[1]); \
    _Pragma("unroll") for(int r_=0;r_<16;++r_)C1[r_]=nmv; PIN(C1); \
    const bf16x8 q1_=QL(1); SBAR(); \
    GAPA(C0=__builtin_amdgcn_mfma_f32_32x32x16_bf16(kf[0],q0p,C1,0,0,0), P0[2],P0[3],P0[4],P0[5],     pw0[0]=PKW(P0,0), pw0[1]=PKW(P0,2), pw0); \
    VRD(4); SBAR(); GAPA(C1=__builtin_amdgcn_mfma_f32_32x32x16_bf16(kf[1],q0p,C1,0,0,0), P0[6],P0[7],P0[8],P0[9],     pw0[2]=PKW(P0,4), pw0[3]=PKW(P0,6), pw0); \
    VRD(1); const bf16x8 q2_=QL(2); SBAR(); GAPA(C0=__builtin_amdgcn_mfma_f32_32x32x16_bf16(kf[2],q1_,C0,0,0,0),   P0[10],P0[11],P0[12],P0[13], pw1[0]=PKW(P0,8), pw1[1]=PKW(P0,10), pw1); \
    VRD(5); SBAR(); GAPA(C1=__builtin_amdgcn_mfma_f32_32x32x16_bf16(kf[3],q1_,C1,0,0,0),   P0[14],P0[15],P1[0],P1[1],   pw1[2]=PKW(P0,12),pw1[3]=PKW(P0,14), pw1); \
    VRD(2); const bf16x8 q3_=QL(3); SBAR(); GAPA(C0=__builtin_amdgcn_mfma_f32_32x32x16_bf16(kf[4],q2_,C0,0,0,0),   P1[2],P1[3],P1[4],P1[5],     pw2[0]=PKW(P1,0), pw2[1]=PKW(P1,2), pw2); \
    VRD(6); SBAR(); GAPA(C1=__builtin_amdgcn_mfma_f32_32x32x16_bf16(kf[5],q2_,C1,0,0,0),   P1[6],P1[7],P1[8],P1[9],     pw2[2]=PKW(P1,4), pw2[3]=PKW(P1,6), pw2); \
    VRD(3); SBAR(); GAPA(C0=__builtin_amdgcn_mfma_f32_32x32x16_bf16(kf[6],q3_,C0,0,0,0),   P1[10],P1[11],P1[12],P1[13], pw3[0]=PKW(P1,8), pw3[1]=PKW(P1,10), pw3); \
    VRD(7); SBAR(); GAPA(C1=__builtin_amdgcn_mfma_f32_32x32x16_bf16(kf[7],q3_,C1,0,0,0),   P1[14],P1[15],0.f,0.f,       pw3[2]=PKW(P1,12),pw3[3]=PKW(P1,14), pw3); \
    l_reg+=sacc; \
    if(GK){DMA_K((t)+3,sl_cur);} if(GV){DMA_V((t)+1,sl_next);} \
    CMASK(C0,C1,t); \
    { float a=MX3(C0[0],C0[1],C1[0]),b=MX3(C0[2],C0[3],C1[1]); a=MX3(a,C1[2],C1[3]); \
      _Pragma("unroll") for(int r=4;r<16;r+=4){a=MX3(a,C0[r],C0[r+1]);b=MX3(b,C0[r+2],C0[r+3]);a=MX3(a,C1[r],C1[r+1]);b=MX3(b,C1[r+2],C1[r+3]);} \
      float rm=__builtin_fmaxf(a,b); { auto rr=__builtin_amdgcn_permlane32_swap(__float_as_uint(rm),__float_as_uint(rm),false,false); rm=__builtin_fmaxf(__uint_as_float(rr[0]),__uint_as_float(rr[1])); } \
      resc=false; \
      if(__builtin_expect(__any(rm>(float)THRL),0)){ const float dl=__builtin_fmaxf(rm,0.f); mhat+=dl; \
        _Pragma("unroll") for(int r=0;r<16;++r){C0[r]-=dl;C1[r]-=dl;} \
        nmv=msk-mhat; \
        const float f=__builtin_amdgcn_exp2f(-dl); l_reg*=f; if(hi==0)wsf[r32]=f; resc=true; } } \
    SBAR(); \
    GAPB(o[0]=__builtin_amdgcn_mfma_f32_32x32x16_bf16(PAF(0),VFR(0),o[0],0,0,0), C0,0); \
    GAPB(o[1]=__builtin_amdgcn_mfma_f32_32x32x16_bf16(PAF(0),VFR(4),o[1],0,0,0), C0,4); \
    KRD(GL,0); GAPB(o[0]=__builtin_amdgcn_mfma_f32_32x32x16_bf16(PAF(1),VFR(1),o[0],0,0,0), C0,8); \
    KRD(GL,1); GAPB(o[1]=__builtin_amdgcn_mfma_f32_32x32x16_bf16(PAF(1),VFR(5),o[1],0,0,0), C0,12); \
    KRD(GL,2); GAPB(o[0]=__builtin_amdgcn_mfma_f32_32x32x16_bf16(PAF(2),VFR(2),o[0],0,0,0), C1,0); \
    KRD(GL,3); GAPB(o[1]=__builtin_amdgcn_mfma_f32_32x32x16_bf16(PAF(2),VFR(6),o[1],0,0,0), C1,4); \
    GAPB(o[0]=__builtin_amdgcn_mfma_f32_32x32x16_bf16(PAF(3),VFR(3),o[0],0,0,0), C1,8); \
    GAPB(o[1]=__builtin_amdgcn_mfma_f32_32x32x16_bf16(PAF(3),VFR(7),o[1],0,0,0), C1,12); \
    }while(0)
  #define ENDW(tt) do{ if((tt)+3<NT){WAIT_BAR(2);} else if((tt)+2<NT){WAIT_BAR(1);} else {WAIT_BAR(0);} }while(0)
  #define UPD(tt) do{ if(((tt)&3)==0){ const int n_=(((tt)-4)>>2)&7; msk=((sel>>n_)&1u)?0.f:-INFINITY; nmv=msk-mhat; } }while(0)
  STEP(pB0,pB1,pA0,pA1,1,(4<NT),true,true); ENDW(1); RESC(); ROT();
  int t=2;
  for(;t+5<NT;t+=2){ UPD(t);
    STEP(pA0,pA1,pB0,pB1,t,true,true,true);     WAIT_BAR(2); RESC(); ROT();
    STEP(pB0,pB1,pA0,pA1,t+1,true,true,true);   WAIT_BAR(2); RESC(); ROT();
  }
  for(;t+2<NT;t+=2){ UPD(t);
    STEP(pA0,pA1,pB0,pB1,t,(t+3<NT),true,true);               ENDW(t);   RESC(); ROT();
    STEP(pB0,pB1,pA0,pA1,t+1,(t+4<NT),(t+2<NT),(t+2<NT));     ENDW(t+1); RESC(); ROT();
  }
  UPD(t);
  STEP(pA0,pA1,pB0,pB1,t,false,true,true); ENDW(t); RESC(); ROT();
  if(nj>=0){ const bf16*nk=ksrc+((long)(nbh-bh)*SEQ+(long)nj*QB)*DM;
    glds16(nk,(unsigned)__builtin_amdgcn_readfirstlane(kdst)); glds16(nk+(long)KVBLK*DM,(unsigned)__builtin_amdgcn_readfirstlane(kdst+SLOTB)); glds16(nk+(long)2*KVBLK*DM,(unsigned)__builtin_amdgcn_readfirstlane(kdst+2*SLOTB));
    if(wid<2) glds16(KM+(size_t)nbh*512+wid*256+lane*4,(unsigned)__builtin_amdgcn_readfirstlane(lds0+LDS_KM+wid*1024)); }
  STEP(pB0,pB1,pA0,pA1,NT-1,false,false,false); RESC();
  if(nj>=0){ const bf16*nq=Q+((long)nbh*SEQ+(long)nj*QB+wid*QBLK+(lane&31))*DM+(lane>>5)*8; const unsigned qdst=lds0+LDS_Q+wid*4096;
    _Pragma("unroll") for(int i=0;i<4;++i) glds16nt(nq+i*16,(unsigned)__builtin_amdgcn_readfirstlane(qdst+i*1024)); }
  #undef UPD
  { float sacc=pB0[0]+pB0[1]; _Pragma("unroll") for(int r=2;r<16;++r)sacc+=pB0[r]; _Pragma("unroll") for(int r=0;r<16;++r)sacc+=pB1[r]; l_reg+=sacc;
    pw0=(u32x4){PKW(pB0,0),PKW(pB0,2),PKW(pB0,4),PKW(pB0,6)};pw1=(u32x4){PKW(pB0,8),PKW(pB0,10),PKW(pB0,12),PKW(pB0,14)};pw2=(u32x4){PKW(pB1,0),PKW(pB1,2),PKW(pB1,4),PKW(pB1,6)};pw3=(u32x4){PKW(pB1,8),PKW(pB1,10),PKW(pB1,12),PKW(pB1,14)};
    SBAR(); pv(o,vb0+sl_cur,PAF(0),PAF(1),PAF(2),PAF(3)); }
  #undef PKW
  #undef PAF
  #undef VFR
  #undef PIN
  #undef MX3
  #undef GAPA
  #undef GAPB
  #undef EX
  #undef VRD
  #undef KRD
  #undef STEP
  #undef ENDW
  {auto rr=__builtin_amdgcn_permlane32_swap(__float_as_uint(l_reg),__float_as_uint(l_reg),false,false);l_reg=__uint_as_float(rr[0])+__uint_as_float(rr[1]);}
  if(hi==0)wsf[32+r32]=l_reg;asm volatile("s_waitcnt lgkmcnt(0)":::"memory");
  float rli[16];
  #pragma unroll
  for(int r=0;r<16;++r)rli[r]=__builtin_amdgcn_rcpf(wsf[32+crow(r,hi)]);
  unsigned short*Mw=MIX+((long)(bh>>3)*SEQ+q0+wid*QBLK)*1024+512+(bh&7)*64;
  { bf16*stg=(bf16*)(shm+LDS_OST)+wid*2048;
    #pragma unroll
    for(int r=0;r<16;++r){const int orow=crow(r,hi);
      #pragma unroll
      for(int d0=0;d0<2;++d0){ bf16*sp_=stg+orow*64+d0*32+r32; *sp_=__float2bfloat16(o[d0][r]*rli[r]*__bfloat162float(*sp_)); } }
    asm volatile("s_waitcnt lgkmcnt(0)":::"memory");
    #pragma unroll
    for(int i=0;i<4;++i){const int row=i*8+(lane>>3),ch=lane&7; const u32x4 v=*(const u32x4*)(stg+row*64+ch*8); *(u32x4*)(Mw+(long)row*1024+ch*8)=v;} }
  asm volatile("s_waitcnt lgkmcnt(0)\n\ts_barrier":::"memory");
  #undef DMA_K
  #undef DMA_V
  #undef QL
  #undef TROW
  #undef CMASK
  #undef START
  #undef RESC
  #undef ROT
}
constexpr int MOBA_LDS_BYTES=LDS_BYTES;
#undef SBAR
#undef WAIT_BAR
#undef BFLO
#undef BFHI
}

struct Args { const float* x; const float* c; const int* pos; const float* pre_g; const float* post_g; const float* w_ada; const float* b_ada; const float* w_in; const float* w_out;
              float* out; unsigned char* ws; };
__constant__ float INV_FREQ[8] = {1.0f, 0.193922743f, 0.0376060307f, 0.00729266461f, 0.00141421356f, 0.000274248188f, 5.3182961e-05f, 1.03133862e-05f};

__global__ void __launch_bounds__(NWAVES * 64, 2) hymba_fwd(Args args) {
    extern __shared__ __attribute__((aligned(16))) unsigned char lds_raw[];
    LAS unsigned char* lds = (LAS unsigned char*)lds_raw;
    volatile LAS unsigned* MISC = (volatile LAS unsigned*)(lds + MISC_OFF);
    const int tid = threadIdx.x, lane = tid & 63, wave = __builtin_amdgcn_readfirstlane(tid >> 6);
    const int G = gridDim.x, bx = blockIdx.x;
    const int gw = bx * NWAVES + wave, NGW = G * NWAVES;
    unsigned char* ws = args.ws;
    gu32* ctl = (gu32*)(ws + WS_CTL);
    bf16* WinT = (bf16*)(ws + WS_WIN); bf16* WoutT = (bf16*)(ws + WS_WOUT);
    float* MOD = (float*)(ws + WS_MOD); _Float16* ROPE = (_Float16*)(ws + WS_ROPE); float* KM = (float*)(ws + WS_KM); float* LSE = (float*)(ws + WS_LSE);
    bf16* QKV = (bf16*)(ws + WS_QKV); bf16* Y = (bf16*)(ws + WS_Y); bf16* OP = (bf16*)(ws + WS_OP); bf16* H = (bf16*)(ws + WS_H); bf16* MIX = (bf16*)(ws + WS_MIX);
    for (int u = tid; u < (EPI_OFF - LDSCTL_OFF) / 4; u += NWAVES * 64) ((LAS unsigned*)(lds + LDSCTL_OFF))[u] = 0u;
    __syncthreads();
    XcdBarrier bar = xcd_barrier_post((unsigned*)(ctl + CW_BAR), MISC + 8);
    if (tid == 0) MISC[12] = __hip_atomic_fetch_add((unsigned*)(ctl + CW_RANK + 64 * bar.x), 1u, __ATOMIC_RELAXED, __HIP_MEMORY_SCOPE_AGENT);
#define GRID_BAR() do { XcdBarrier b2_ = bar; asm volatile("" : "+s"(b2_.x)); xcd_barrier(b2_); } while (0)
#define PHASE_IDS() int tid_o = threadIdx.x; asm volatile("" : "+v"(tid_o)); const int tid = tid_o, lane = tid & 63, wave = __builtin_amdgcn_readfirstlane(tid >> 6), gw = bx * NWAVES + wave; (void)gw; (void)lane

    for (int rep0_ = 0; rep0_ < REP_P0; ++rep0_) {
        LAS float* sc = (LAS float*)lds;
        LAS float* red = (LAS float*)(lds + 65536);
        if (bx < 192) {
            for (int i = tid; i < NB * DM; i += NWAVES * 64) { const float v = args.c[i]; sc[i] = v / (1.f + __expf(-v)); }
            __syncthreads();
            for (int item = bx; item < 192; item += G) {
                const int l = item / 96, e0 = (item % 96) * 32, el = tid & 31, dc = tid >> 5;
                float a[NB];
#pragma unroll
                for (int b = 0; b < NB; ++b) a[b] = 0.f;
                const float* wp = args.w_ada + (size_t)l * DM * 3072 + (size_t)(dc * 64) * 3072 + e0 + el;
                float w[64];
#pragma unroll
                for (int k = 0; k < 64; ++k) w[k] = __builtin_nontemporal_load(wp + (size_t)k * 3072);
#pragma unroll
                for (int bt = 0; bt < 4; ++bt) {
                    asm volatile("" : "+v"(w[bt * 16 + 0]), "+v"(w[bt * 16 + 1]), "+v"(w[bt * 16 + 2]), "+v"(w[bt * 16 + 3]), "+v"(w[bt * 16 + 4]), "+v"(w[bt * 16 + 5]), "+v"(w[bt * 16 + 6]), "+v"(w[bt * 16 + 7]),
                                        "+v"(w[bt * 16 + 8]), "+v"(w[bt * 16 + 9]), "+v"(w[bt * 16 + 10]), "+v"(w[bt * 16 + 11]), "+v"(w[bt * 16 + 12]), "+v"(w[bt * 16 + 13]), "+v"(w[bt * 16 + 14]), "+v"(w[bt * 16 + 15]));
#pragma unroll
                    for (int k4 = 0; k4 < 4; ++k4)
#pragma unroll
                        for (int b = 0; b < NB; ++b) { const f32x4 s4 = *(LAS const f32x4*)(sc + b * DM + dc * 64 + bt * 16 + k4 * 4);
                            a[b] += (s4.x * w[bt * 16 + 4 * k4] + s4.y * w[bt * 16 + 4 * k4 + 1]) + (s4.z * w[bt * 16 + 4 * k4 + 2] + s4.w * w[bt * 16 + 4 * k4 + 3]); }
                }
#pragma unroll
                for (int b = 0; b < NB; ++b) red[(dc * NB + b) * 32 + el] = a[b];
                __syncthreads();
                { const int b = tid >> 5; float s = 0.f;
#pragma unroll
                  for (int k = 0; k < 16; ++k) s += red[(k * NB + b) * 32 + el];
                  MOD[((size_t)l * NB + b) * 3072 + e0 + el] = s + args.b_ada[(size_t)l * 3072 + e0 + el]; }
                __syncthreads();
            }
        }
        else {
            LAS float* scr = (LAS float*)(lds + wave * 16384);
            constexpr int I_OUT = (DM / 64) * (DM / 32);
            for (int it = (bx - 192) * NWAVES + wave; it < DEPTH * I_OUT; it += (G - 192) * NWAVES) { const int l = it / I_OUT;
                p0_transpose_item(args.w_out + (size_t)l * DM * DM, DM, DM, WoutT + (size_t)l * DM * DM, 0, scr, it % I_OUT, lane); }
            for (int i = (bx - 192) * (NWAVES * 64) + tid; i < MROWS * 8; i += (G - 192) * NWAVES * 64) { const int row = i >> 3, f = i & 7;
                const float ang = (float)args.pos[row] * INV_FREQ[f];
                ROPE[(size_t)row * 16 + f] = (_Float16)cosf(ang); ROPE[(size_t)row * 16 + 8 + f] = (_Float16)sinf(ang); }
        }
    }
    GRID_BAR();
    if (tid == 0) { unsigned base = 0u; for (unsigned jx = 0; jx < bar.x; ++jx) base += xb_ld((unsigned*)(ctl + CW_BAR) + XB_XCNT(jx)); MISC[13] = base + MISC[12]; }
    __syncthreads();

    for (int rep1_ = 0; rep1_ < REP_P1; ++rep1_) {
        {
            LAS float* scr = (LAS float*)(lds + wave * 16384);
            constexpr int I_IN = (DM / 64) * (DIN / 32);
            for (int it = gw; it < DEPTH * I_IN; it += NGW) { const int l = it / I_IN;
                p0_transpose_item(args.w_in + (size_t)l * DM * DIN, DM, DIN, WinT + (size_t)l * DIN * DM, 0, scr, it % I_IN, lane); }
        }
        const int RPW = MROWS / NGW;
        const int row0 = (((bx % 8) * (G / 8) + bx / 8) * NWAVES + wave) * RPW, b = row0 / SEQ;
        const float* mod = MOD + (size_t)b * 3072;
        f32x4 A1[4], B1[4];
#pragma unroll
        for (int jj = 0; jj < 4; ++jj) { const int c = 4 * lane + 256 * jj; const f32x4 pg = *(const f32x4*)(args.pre_g + c), scl = *(const f32x4*)(mod + 1024 + c);
            A1[jj] = pg * (scl + 1.f); B1[jj] = *(const f32x4*)(mod + c); }
        for (int rg = row0; rg < row0 + RPW; rg += 4) {
            f32x4 v[4][4];
#pragma unroll
            for (int q = 0; q < 4; ++q) { const f32x4* xr = (const f32x4*)(args.x + (size_t)(rg + q) * DM) + lane;
#pragma unroll
                for (int jj = 0; jj < 4; ++jj) v[q][jj] = __builtin_nontemporal_load(xr + 64 * jj); }
#pragma unroll
            for (int q = 0; q < 4; ++q) { const int row = rg + q; float s = 0.f;
#pragma unroll
                for (int jj = 0; jj < 4; ++jj) s += (v[q][jj].x * v[q][jj].x + v[q][jj].y * v[q][jj].y) + (v[q][jj].z * v[q][jj].z + v[q][jj].w * v[q][jj].w);
                const float rstd = 1.f / sqrtf(wave_sum(s) * (1.f / DM) + RMS_EPS);
                unsigned long long* o8 = (unsigned long long*)(H + (size_t)row * DM) + lane;
#pragma unroll
                for (int jj = 0; jj < 4; ++jj) { const f32x4 hv = v[q][jj] * rstd * A1[jj] + B1[jj];
                    o8[64 * jj] = (unsigned long long)pk2(hv.x, hv.y) | ((unsigned long long)pk2(hv.z, hv.w) << 32); }
            }
        }
    }
    GRID_BAR();

    for (int layer = 0; layer < DEPTH; ++layer) {
        GAS unsigned char* wsl; { unsigned long long wsi_ = (unsigned long long)ws; asm volatile("" : "+s"(wsi_)); wsl = (GAS unsigned char*)wsi_; }
        int bxo_ = blockIdx.x; asm volatile("" : "+s"(bxo_)); const int bx = bxo_;
        bf16* WinT = (bf16*)(wsl + WS_WIN); bf16* WoutT = (bf16*)(wsl + WS_WOUT); float* MOD = (float*)(wsl + WS_MOD); _Float16* ROPE = (_Float16*)(wsl + WS_ROPE); float* KM = (float*)(wsl + WS_KM); float* LSE = (float*)(wsl + WS_LSE);
        bf16* QKV = (bf16*)(wsl + WS_QKV); bf16* Y = (bf16*)(wsl + WS_Y); bf16* OP = (bf16*)(wsl + WS_OP); bf16* H = (bf16*)(wsl + WS_H); bf16* MIX = (bf16*)(wsl + WS_MIX);
#ifndef SKIP_P2
        for (int rep_ = 0; rep_ < REP_P2; ++rep_) {
            pg8::Gemm g{H, WinT + (size_t)layer * DIN * DM, MROWS, DIN, DM}; pg8::StaticOrder S; S.init(MROWS, DIN, G, bx, 1);
            pg8::EpiProj E{QKV, ROPE, lds + EPI_OFF, lds + pg8::STAGE_BYTES};
            pg8::gemm_phase<pg8::EpiProj, pg8::StaticOrder, true, true>(lds, g, S, E);
        }
#endif
        GRID_BAR();
#ifndef SKIP_P3A
        for (int rep_ = 0; rep_ < REP_P3A; ++rep_) {
            PHASE_IDS();
            const int vcu = (int)__builtin_amdgcn_readfirstlane(MISC[13]);
            const int xg = (vcu >> 5) * 4 + ((vcu & 31) >> 3), mem = vcu & 7;
            att3::run_units<false>(8, [&](int k) { const int pi = (mem + 2 * (k >> 1)) & 7; return att3::make_unit((k >> 1) * 32 + xg, (int)((((k & 1) ? 0xFB754321u : 0xD96ECA80u) >> (4 * pi)) & 15u)); }, QKV, QKV + TSZ, QKV + 2 * TSZ, QKV + 3 * TSZ, OP, LSE, MIX, (LAS char*)lds);
            const bf16* KBp = QKV + 5 * TSZ;
            for (int t = gw; t < NB * NH * 8; t += NGW) {
                const int rg = lane >> 3, ch = lane & 7; float acc[8];
#pragma unroll
                for (int k = 0; k < 8; ++k) acc[k] = 0.f;
                const bf16* kp = KBp + ((size_t)t * 256 + rg) * 64 + ch * 8;
#pragma unroll 4
                for (int it = 0; it < 32; ++it) { const v4u w = *(const v4u*)(kp + (size_t)it * 8 * 64);
                    acc[0] += bflo(w.x); acc[1] += bfhi(w.x); acc[2] += bflo(w.y); acc[3] += bfhi(w.y); acc[4] += bflo(w.z); acc[5] += bfhi(w.z); acc[6] += bflo(w.w); acc[7] += bfhi(w.w); }
#pragma unroll
                for (int k = 0; k < 8; ++k) { acc[k] += __shfl_xor(acc[k], 8); acc[k] += __shfl_xor(acc[k], 16); acc[k] += __shfl_xor(acc[k], 32); }
                if (lane < 8) { float* o = KM + (size_t)t * 64 + ch * 8;
                    *(f32x4*)o = (f32x4){acc[0], acc[1], acc[2], acc[3]} * (1.f / 256.f); *(f32x4*)(o + 4) = (f32x4){acc[4], acc[5], acc[6], acc[7]} * (1.f / 256.f); }
            }
        }
#endif
        GRID_BAR();
#ifndef SKIP_P3B
        for (int rep_ = 0; rep_ < REP_P3B; ++rep_) {
            PHASE_IDS();
            const int vcu = (int)__builtin_amdgcn_readfirstlane(MISC[13]);
            const int xg = (vcu >> 5) * 4 + ((vcu & 31) >> 3), mem = vcu & 7;
            const int cpos = xg & 3;
            for (int ph = 0; ph < 5; ++ph) {
                if (ph == cpos) {
                    att3::run_units<true>(4, [&](int k) { return att3::make_unit(k * 32 + xg, 16 + mem); }, QKV, QKV + TSZ, QKV + 2 * TSZ, QKV + 3 * TSZ, OP, LSE, MIX, (LAS char*)lds);
                } else { const int k = ph - (ph > cpos); const int bh = k * 32 + xg;
                    auto jof = [&](int kk) { return (kk == 0) ? mem : (kk == 1) ? 7 - mem : (kk == 2) ? ((mem + 4) & 7) : 7 - ((mem + 4) & 7); };
                    const bool pre = (k > 0) && (k != cpos), nxt = (k + 1 < 4) && (k + 1 != cpos);
                    attb::moba_unit<8>(bh, jof(k), (const attb::bf16*)(QKV + 4 * TSZ), (const attb::bf16*)(QKV + 5 * TSZ), (const attb::bf16*)(QKV + 6 * TSZ), QKV + 7 * TSZ, KM, MIX, (char*)lds_raw, pre, (k + 1) * 32 + xg, nxt ? jof(k + 1) : -1); }
            }
        }
#endif
        GRID_BAR();
#ifndef SKIP_P4
        for (int rep_ = 0; rep_ < REP_P4; ++rep_) {
            pg8::Gemm g{MIX, WoutT + (size_t)layer * DM * DM, MROWS, DM, DM}; pg8::StaticOrder S; S.init(MROWS, DM, G, bx);
            pg8::EpiPlain E{Y, DM, lds + EPI_OFF};
            pg8::gemm_phase<pg8::EpiPlain, pg8::StaticOrder, true, true>(lds, g, S, E);
        }
#endif
        GRID_BAR();
#ifndef SKIP_P5
        for (int rep_ = 0; rep_ < REP_P5; ++rep_) {
            PHASE_IDS();
            const int RPW = MROWS / NGW; const int row0 = (((bx % 8) * (G / 8) + bx / 8) * NWAVES + wave) * RPW, b = row0 / SEQ;
            const float* mod = MOD + ((size_t)layer * NB + b) * 3072;
            const float* modn = MOD + ((size_t)(layer + 1 < DEPTH ? layer + 1 : layer) * NB + b) * 3072;
            const float* pgn = args.pre_g + (size_t)(layer + 1 < DEPTH ? layer + 1 : layer) * DM;
            const bool has_next = layer + 1 < DEPTH;
            bf16* X1B = (bf16*)(wsl + WS_X1B);
            f32x4 G2[4], A1[4], B1[4];
#pragma unroll
            for (int jj = 0; jj < 4; ++jj) { const int c = 4 * lane + 256 * jj;
                G2[jj] = *(const f32x4*)(mod + 2048 + c) * *(const f32x4*)(args.post_g + (size_t)layer * DM + c);
                A1[jj] = *(const f32x4*)(pgn + c) * (*(const f32x4*)(modn + 1024 + c) + 1.f); B1[jj] = *(const f32x4*)(modn + c); }
            for (int rg = row0; rg < row0 + RPW; rg += 4) {
                f32x4 xq[4][4]; v2u yq[4][4];
#pragma unroll
                for (int q = 0; q < 4; ++q) { const v2u* yr = (const v2u*)(Y + (size_t)(rg + q) * DM) + lane;
                    if (layer == 0) { const f32x4* xr = (const f32x4*)(args.x + (size_t)(rg + q) * DM) + lane;
#pragma unroll
                        for (int jj = 0; jj < 4; ++jj) xq[q][jj] = __builtin_nontemporal_load(xr + 64 * jj);
                    } else { const v2u* xr = (const v2u*)(X1B + (size_t)(rg + q) * DM) + lane;
#pragma unroll
                        for (int jj = 0; jj < 4; ++jj) { const v2u w = __builtin_nontemporal_load(xr + 64 * jj); xq[q][jj] = (f32x4){bflo(w.x), bfhi(w.x), bflo(w.y), bfhi(w.y)}; } }
#pragma unroll
                    for (int jj = 0; jj < 4; ++jj) yq[q][jj] = __builtin_nontemporal_load(yr + 64 * jj); }
#pragma unroll
                for (int q = 0; q < 4; ++q) { const int row = rg + q;
                    f32x4 xv[4], yv[4]; float s = 0.f;
#pragma unroll
                    for (int jj = 0; jj < 4; ++jj) { xv[jj] = xq[q][jj]; const v2u w = yq[q][jj]; yv[jj] = (f32x4){bflo(w.x), bfhi(w.x), bflo(w.y), bfhi(w.y)};
                        s += (yv[jj].x * yv[jj].x + yv[jj].y * yv[jj].y) + (yv[jj].z * yv[jj].z + yv[jj].w * yv[jj].w); }
                    const float rstd = 1.f / sqrtf(wave_sum(s) * (1.f / DM) + RMS_EPS);
                    float s2 = 0.f;
                    f32x4* orow = (f32x4*)(args.out + (size_t)row * DM) + lane; v2u* xrow = (v2u*)(X1B + (size_t)row * DM) + lane;
#pragma unroll
                    for (int jj = 0; jj < 4; ++jj) { xv[jj] = xv[jj] + G2[jj] * (yv[jj] * rstd);
                        if (has_next) __builtin_nontemporal_store((v2u){pk2(xv[jj].x, xv[jj].y), pk2(xv[jj].z, xv[jj].w)}, xrow + 64 * jj); else __builtin_nontemporal_store(xv[jj], orow + 64 * jj);
                        s2 += (xv[jj].x * xv[jj].x + xv[jj].y * xv[jj].y) + (xv[jj].z * xv[jj].z + xv[jj].w * xv[jj].w); }
                    if (has_next) {
                        const float rstd2 = 1.f / sqrtf(wave_sum(s2) * (1.f / DM) + RMS_EPS);
                        unsigned long long* o8 = (unsigned long long*)(H + (size_t)row * DM) + lane;
#pragma unroll
                        for (int jj = 0; jj < 4; ++jj) { const f32x4 hv = xv[jj] * rstd2 * A1[jj] + B1[jj];
                            o8[64 * jj] = (unsigned long long)pk2(hv.x, hv.y) | ((unsigned long long)pk2(hv.z, hv.w) << 32); }
                    }
                }
            }
        }
#endif
        if (layer + 1 < DEPTH) GRID_BAR();
    }
}

extern "C" void kernel_launch(void* const* d_in, const int* in_sizes, int n_in, void* d_out, int out_size, void* d_ws, size_t ws_size, hipStream_t stream) {
    static int grid = 0;
    if (grid == 0) {
        if (n_in != 9 || in_sizes[0] != MROWS * DM || out_size != MROWS * DM || ws_size < WS_END) { fprintf(stderr, "kernel_launch: unexpected problem shape (n_in %d, ws %zu)\n", n_in, ws_size); grid = -1; return; }
        int dev = 0, cus = 0, per_cu = 0;
        if (hipGetDevice(&dev) != hipSuccess || hipDeviceGetAttribute(&cus, hipDeviceAttributeMultiprocessorCount, dev) != hipSuccess) { grid = -1; return; }
        if (hipFuncSetAttribute((const void*)hymba_fwd, hipFuncAttributeMaxDynamicSharedMemorySize, LDS_BYTES) != hipSuccess) { fprintf(stderr, "kernel_launch: hipFuncSetAttribute failed\n"); grid = -1; return; }
        if (hipOccupancyMaxActiveBlocksPerMultiprocessor(&per_cu, (const void*)hymba_fwd, NWAVES * 64, LDS_BYTES) != hipSuccess || per_cu < 1) { fprintf(stderr, "kernel_launch: occupancy query reports %d\n", per_cu); }
        (void)hipGetLastError();
        grid = cus;
        if (grid != 256) { fprintf(stderr, "kernel_launch: built for a 256-CU device, found %d CUs\n", cus); grid = -1; return; }
    }
    if (grid < 0) return;
    if (hipMemsetAsync((char*)d_ws + WS_CTL, 0, CTL_ZERO_BYTES, stream) != hipSuccess) return;
    Args a{};
    a.x = (const float*)d_in[0]; a.c = (const float*)d_in[1]; a.pos = (const int*)d_in[2]; a.pre_g = (const float*)d_in[3]; a.post_g = (const float*)d_in[4];
    a.w_ada = (const float*)d_in[5]; a.b_ada = (const float*)d_in[6]; a.w_in = (const float*)d_in[7]; a.w_out = (const float*)d_in[8];
    a.out = (float*)d_out; a.ws = (unsigned char*)d_ws;
    hipLaunchKernelGGL(hymba_fwd, dim3(grid), dim3(NWAVES * 64), LDS_BYTES, stream, a);
}
```

```cpp
#include <hip/hip_runtime.h>
#include <hip/hip_bf16.h>
#include <cmath>
#include <cstdio>
#include <cstdint>

constexpr int NB = 16, SEQ = 2048, DM = 1024, NH = 8, HD = 64, DIN = 4096, MROWS = NB * SEQ, DEPTH = 2;
constexpr float RMS_EPS = 1e-6f;
constexpr float C2 = 0.125f * 1.4426950408889634f;
constexpr float NEGBIG = -1.0e30f;
constexpr size_t TSZ = (size_t)NB * NH * SEQ * HD;
namespace pg8 {
#define PG8_LAS __attribute__((address_space(3)))
typedef unsigned short bf16_t;
typedef short bf16x8 __attribute__((ext_vector_type(8)));
typedef float f32x4 __attribute__((ext_vector_type(4)));
typedef unsigned u32x4 __attribute__((ext_vector_type(4)));
constexpr int BM = 256, BK = 64, HALF = 128, HTB = HALF * BK * 2  , STAGE_BYTES = 8 * HTB, NXCD = 8, WGM = 8;

__host__ __device__ __forceinline__ int lds_byte(int r, int c) { const int st = (r >> 4) * 2 + (c >> 5), rr = r & 15, cc = c & 31, ob = rr * 64 + cc * 2; return st * 1024 + (ob ^ (((ob >> 9) & 1) << 5)); }
__host__ __device__ __forceinline__ void stage_rc(int b, int& R, int& C) { const int st = b / 1024, sb = b % 1024, swz = sb ^ (((sb >> 9) & 1) << 5); R = (st >> 1) * 16 + swz / 64; C = (st & 1) * 32 + (swz % 64) / 2; }
__host__ __device__ __forceinline__ int perm32(int rho) { const int n = rho >> 4, i = rho & 15; return 8 * (i >> 2) + 4 * n + (i & 3); }

struct Unit { int pm, pn; };
struct Gemm { const bf16_t* A; const bf16_t* Bt; int M, N, K; };

struct StaticOrder {
    int nM, nN, nwg, G, c, mix;
    __host__ __device__ void init(int M, int N, int G_, int c_, int mix_ = 0) { nM = M / BM; nN = N / BM; nwg = nM * nN; G = G_; c = c_; mix = mix_; }
    __host__ __device__ bool next(int i, Unit& u) const {
        const long L = (long)i * G + c; if (L >= nwg) return false;
        int wgid = (int)L; { const int q = nwg / NXCD, r = nwg % NXCD, xcd = wgid % NXCD, off = wgid / NXCD; wgid = (xcd < r ? xcd * (q + 1) : r * (q + 1) + (xcd - r) * q) + off; }
        const int nig = WGM * nN, gid = wgid / nig, fm = gid * WGM, gsz = (nM - fm) < WGM ? (nM - fm) : WGM;
        u.pm = fm + ((wgid % nig) % gsz); u.pn = (wgid % nig) / gsz;
        if (mix) { const int t = u.pn >> 2, j = u.pn & 3; u.pn = 8 * (j >> 1) + 2 * ((t + j) & 3) + (j & 1); }
        return true;
    }
    __device__ __forceinline__ void a_ready(const Unit&) const {}
    __device__ __forceinline__ void done(const Unit&) const {}
};
__device__ __forceinline__ unsigned cvt_pk_bf16(float lo, float hi) { unsigned r; asm volatile("v_cvt_pk_bf16_f32 %0, %1, %2" : "=v"(r) : "v"(lo), "v"(hi)); return r; }
typedef _Float16 f16x8 __attribute__((ext_vector_type(8)));
constexpr int EPI_WST = 16 * 144;
struct EpiPlain {
    static constexpr bool PERM = true, AFTER_DRAIN = false, HPW = true, PREFETCH = false;
    bf16_t* O; int ldc; PG8_LAS unsigned char* st;
    __device__ __forceinline__ void operator()(const f32x4 (&acc)[2][2][4][2], const Unit& u, int wr, int wc, int fr_, int fq_) const {
        int tl_ = threadIdx.x; asm volatile("" : "+v"(tl_)); const int fr = tl_ & 15, fq = (tl_ >> 4) & 3; (void)fr_; (void)fq_;
        const int lane = fq * 16 + fr;
        PG8_LAS unsigned char* wst = st + (wr * 4 + wc) * EPI_WST;
        PG8_LAS unsigned char* wp = wst + fr * 144 + fq * 16; const PG8_LAS unsigned char* rp = wst + (lane >> 3) * 144 + (lane & 7) * 16;
        bf16_t* ob = O + (size_t)(u.pm * BM + wr * 64 + (lane >> 3)) * ldc + u.pn * BM + wc * 64 + (lane & 7) * 8;
        u32x4 rq[2];
#pragma unroll
        for (int it = 0; it < 9; ++it) { const int ai = (it & 7) >> 2, m = it & 3;
            u32x4 rn[2];
            if (it < 8) {
#pragma unroll
                for (int bj = 0; bj < 2; ++bj) { const f32x4 v0 = acc[ai][bj][m][0], v1 = acc[ai][bj][m][1];
                    u32x4 w; w.x = cvt_pk_bf16(v0[0], v0[1]); w.y = cvt_pk_bf16(v0[2], v0[3]); w.z = cvt_pk_bf16(v1[0], v1[1]); w.w = cvt_pk_bf16(v1[2], v1[3]);
                    *(PG8_LAS u32x4*)(wp + bj * 64) = w; }
#pragma unroll
                for (int h = 0; h < 2; ++h) rn[h] = *(const PG8_LAS u32x4*)(rp + h * 8 * 144);
            }
            if (it > 0) { const int pa = (it - 1) >> 2, pm_ = (it - 1) & 3;
#pragma unroll
                for (int h = 0; h < 2; ++h) *(u32x4*)(ob + (size_t)(pa * HALF + pm_ * 16 + h * 8) * ldc) = rq[h]; }
            if (it < 8) { rq[0] = rn[0]; rq[1] = rn[1]; }
        }
    }
};
struct EpiProj {
    static constexpr bool PERM = true, AFTER_DRAIN = false, HPW = true, PREFETCH = true;
    bf16_t* qkv; const _Float16* rope; PG8_LAS unsigned char* st; PG8_LAS unsigned char* rl;
    __device__ __forceinline__ void prefetch(const Unit& u, int wid) const {
        if (((u.pn >> 1) & 3) < 2) { int tl_ = threadIdx.x; asm volatile("" : "+v"(tl_));
            __builtin_amdgcn_global_load_lds((const unsigned*)(rope + (size_t)u.pm * 256 * 16 + wid * 512 + (tl_ & 63) * 8), (PG8_LAS unsigned*)(rl + wid * 1024), 16, 0, 0); }
    }
    __device__ __forceinline__ void operator()(const f32x4 (&acc)[2][2][4][2], const Unit& u, int wr, int wc, int fr_, int fq_) const {
        int tl_ = threadIdx.x; asm volatile("" : "+v"(tl_)); const int fr = tl_ & 15, fq = (tl_ >> 4) & 3; (void)fr_; (void)fq_;
        const int tensor = u.pn >> 1, kind = tensor & 3, lane = fq * 16 + fr;
        const int b = u.pm >> 3, sb = (u.pm & 7) * 256 + wr * 64;
        const bool roped = (kind < 2);
        const float sg = (fq == 0) ? -1.f : 1.f;
        PG8_LAS unsigned char* wst = st + (wr * 4 + wc) * EPI_WST;
        PG8_LAS unsigned char* wp = wst + fr * 144 + fq * 16; const PG8_LAS unsigned char* rp = wst + (lane >> 3) * 144 + (lane & 7) * 16;
        const PG8_LAS unsigned char* rr = rl + (wr * 64 + fr) * 32;
        bf16_t* ob = qkv + (size_t)tensor * TSZ + ((size_t)(b * 8 + (u.pn & 1) * 4 + wc) * 2048 + sb) * 64 + lane * 8;
        u32x4 rq[2];
#pragma unroll
        for (int it = 0; it < 9; ++it) { const int ai = (it & 7) >> 2, m = it & 3;
            u32x4 rn[2];
            if (it < 8) {
#pragma unroll
                for (int bj = 0; bj < 2; ++bj) {
                    f32x4 v0 = acc[ai][bj][m][0], v1 = acc[ai][bj][m][1];
                    if (roped && bj == 0) {
                        const f16x8 c8 = *(const PG8_LAS f16x8*)(rr + (ai * HALF + m * 16) * 32), s8 = *(const PG8_LAS f16x8*)(rr + (ai * HALF + m * 16) * 32 + 16);
                        f32x4 p0, p1;
#pragma unroll
                        for (int c = 0; c < 4; ++c) { p0[c] = __shfl_xor(v0[c], 16); p1[c] = __shfl_xor(v1[c], 16); }
                        if (fq < 2) {
                            const f32x4 c0 = {(float)c8[0], (float)c8[1], (float)c8[2], (float)c8[3]}, c1 = {(float)c8[4], (float)c8[5], (float)c8[6], (float)c8[7]};
                            const f32x4 s0 = {(float)s8[0], (float)s8[1], (float)s8[2], (float)s8[3]}, s1 = {(float)s8[4], (float)s8[5], (float)s8[6], (float)s8[7]};
                            v0 = v0 * c0 + sg * (p0 * s0); v1 = v1 * c1 + sg * (p1 * s1); }
                    }
                    if (kind == 0) { v0 = v0 * C2; v1 = v1 * C2; }
                    if (kind == 3) {
#pragma unroll
                        for (int c = 0; c < 4; ++c) { v0[c] = v0[c] * __builtin_amdgcn_rcpf(1.f + __builtin_amdgcn_exp2f(-1.4426950408889634f * v0[c])); v1[c] = v1[c] * __builtin_amdgcn_rcpf(1.f + __builtin_amdgcn_exp2f(-1.4426950408889634f * v1[c])); }
                    }
                    u32x4 w; w.x = cvt_pk_bf16(v0[0], v0[1]); w.y = cvt_pk_bf16(v0[2], v0[3]); w.z = cvt_pk_bf16(v1[0], v1[1]); w.w = cvt_pk_bf16(v1[2], v1[3]);
                    *(PG8_LAS u32x4*)(wp + bj * 64) = w;
                }
#pragma unroll
                for (int h = 0; h < 2; ++h) rn[h] = *(const PG8_LAS u32x4*)(rp + h * 8 * 144);
            }
            if (it > 0) { const int pa = (it - 1) >> 2, pm_ = (it - 1) & 3;
#pragma unroll
                for (int h = 0; h < 2; ++h) __builtin_nontemporal_store(rq[h], (u32x4*)(ob + (size_t)(pa * HALF + pm_ * 16) * 64 + h * 512)); }
            if (it < 8) { rq[0] = rn[0]; rq[1] = rn[1]; }
        }
    }
};
template <class Epi, class Sched, bool ALIGN_EPI = false, bool SP2 = false>
__device__ __forceinline__ void gemm_phase(PG8_LAS unsigned char* lds, const Gemm g, const Sched& S, const Epi& E) {
    int tid_o = threadIdx.x; asm volatile("" : "+v"(tid_o));
    const int tid = tid_o, wid = __builtin_amdgcn_readfirstlane(tid >> 6), lane = tid & 63, wr = wid >> 2, wc = wid & 3, fr = lane & 15, fq = lane >> 4;
    const int K = g.K, nt = K / BK;
    unsigned voffA[2], voffB[2]; int aoff, boff;
#define PG8_LANE_OFFS() do { int t_ = threadIdx.x; asm volatile("" : "+v"(t_)); const int fr_ = t_ & 15, fq_ = (t_ >> 4) & 3; \
        _Pragma("unroll") for (int i = 0; i < 2; ++i) { int R, C; stage_rc(t_ * 16 + i * 8192, R, C); const int Rb = Epi::PERM ? ((R & ~31) + perm32(R & 31)) : R; \
            voffA[i] = (unsigned)(R * K + C) * 2u; voffB[i] = Epi::HPW ? (unsigned)(((R >> 5) * 64 + perm32(R & 31)) * K + C) * 2u : (unsigned)(Rb * K + C) * 2u; } \
        aoff = lds_byte(wr * 64 + fr_, fq_ * 8); boff = lds_byte(wc * 32 + fr_, fq_ * 8); } while (0)
    PG8_LANE_OFFS();
    const size_t kstep = (size_t)(BK * 2);
    const size_t hstep = (size_t)HALF * K * 2;
    const size_t bstep = Epi::HPW ? (size_t)32 * K * 2 : hstep;
    const size_t tstep = 2 * hstep;
    const unsigned ldsw = (unsigned)wid * 1024u;
#define PG8_SA(b, h) (((b) * 2 + (h)) * HTB)
#define PG8_SB(b, h) ((4 + (b) * 2 + (h)) * HTB)
#define PG8_STAGE(bufoff, gbase, voff) do { _Pragma("unroll") for (int _i = 0; _i < 2; ++_i) \
        __builtin_amdgcn_global_load_lds((const unsigned*)((const char*)(gbase) + (voff)[_i]), (PG8_LAS unsigned*)(lds + (bufoff) + ldsw + _i * 8192), 16, 0, 0); } while (0)
#define PG8_LDA(dst, b, h) do { _Pragma("unroll") for (int m = 0; m < 4; ++m) _Pragma("unroll") for (int k = 0; k < 2; ++k) dst[m][k] = *(const PG8_LAS bf16x8*)(lds + PG8_SA(b, h) + aoff + m * 2048 + k * 1024); } while (0)
#define PG8_LDB(dst, b, h) do { _Pragma("unroll") for (int n = 0; n < 2; ++n) _Pragma("unroll") for (int k = 0; k < 2; ++k) dst[n][k] = *(const PG8_LAS bf16x8*)(lds + PG8_SB(b, h) + boff + n * 2048 + k * 1024); } while (0)
#define PG8_MMA(ai, bj, At, Bt) do { __builtin_amdgcn_s_setprio(1); _Pragma("unroll") for (int m = 0; m < 4; ++m) _Pragma("unroll") for (int n = 0; n < 2; ++n) _Pragma("unroll") for (int k = 0; k < 2; ++k) \
        acc[ai][bj][m][n] = __builtin_amdgcn_mfma_f32_16x16x32_bf16(Bt[n][k], At[m][k], acc[ai][bj][m][n], 0, 0, 0); __builtin_amdgcn_s_setprio(0); } while (0)
#define PG8_WAIT_V(n) asm volatile("s_waitcnt vmcnt(" #n ")" ::: "memory")
#define PG8_WAIT_L(n) asm volatile("s_waitcnt lgkmcnt(" #n ")" ::: "memory")
#define PG8_BAR __builtin_amdgcn_s_barrier()
#define PG8_SCHED __builtin_amdgcn_sched_barrier(0)
    Unit cur, nxt; int ui = 0;
    if (!S.next(0, cur)) return;
    f32x4 acc[2][2][4][2];
#pragma unroll
    for (int a = 0; a < 2; ++a)
#pragma unroll
        for (int b = 0; b < 2; ++b)
#pragma unroll
            for (int m = 0; m < 4; ++m)
#pragma unroll
                for (int n = 0; n < 2; ++n) acc[a][b][m][n] = (f32x4){0.f, 0.f, 0.f, 0.f};
    bf16x8 At[4][2], B0[2][2], B1[2][2];
    const char* cA = (const char*)g.A + (size_t)cur.pm * tstep; const char* cB = (const char*)g.Bt + (size_t)cur.pn * tstep;
    S.a_ready(cur);
    if constexpr (SP2) {
        PG8_STAGE(PG8_SB(0, 0), cB, voffB); PG8_STAGE(PG8_SB(0, 1), cB + bstep, voffB); PG8_STAGE(PG8_SA(0, 0), cA, voffA); PG8_STAGE(PG8_SA(0, 1), cA + hstep, voffA);
        if (wr == 1) PG8_BAR;
        PG8_WAIT_V(2); PG8_BAR;
        PG8_STAGE(PG8_SB(1, 0), cB + kstep, voffB); PG8_STAGE(PG8_SA(1, 0), cA + kstep, voffA); PG8_STAGE(PG8_SB(1, 1), cB + bstep + kstep, voffB);
        PG8_WAIT_V(6); PG8_BAR;
    } else {
        PG8_STAGE(PG8_SB(0, 0), cB, voffB); PG8_STAGE(PG8_SA(0, 0), cA, voffA); PG8_STAGE(PG8_SB(0, 1), cB + bstep, voffB); PG8_STAGE(PG8_SA(0, 1), cA + hstep, voffA);
        if (wr == 1) PG8_BAR;
        PG8_WAIT_V(4); PG8_BAR;
        PG8_STAGE(PG8_SB(1, 0), cB + kstep, voffB); PG8_STAGE(PG8_SA(1, 0), cA + kstep, voffA); PG8_STAGE(PG8_SB(1, 1), cB + bstep + kstep, voffB);
        PG8_WAIT_V(6); PG8_BAR;
    }
    for (;;) {
        const bool has_next = S.next(ui + 1, nxt);
        const char* nA = has_next ? (const char*)g.A + (size_t)nxt.pm * tstep : cA; const char* nB = has_next ? (const char*)g.Bt + (size_t)nxt.pn * tstep : cB;
        for (int t = 0; t < nt; t += 2) {
            const bool last = (t == nt - 2);
            if constexpr (Epi::PREFETCH) { if (t == 2) E.prefetch(cur, wid); }
            const char* a1 = cA + (size_t)(t + 1) * kstep;
            const char* a2 = last ? nA : cA + (size_t)(t + 2) * kstep; const char* b2 = last ? nB : cB + (size_t)(t + 2) * kstep;
            const char* a3 = a2 + kstep; const char* b3 = b2 + kstep;
            if (last && has_next) S.a_ready(nxt);
            if constexpr (SP2) {
            PG8_LDB(B0, 0, 0); PG8_LDB(B1, 0, 1); PG8_SCHED; PG8_LDA(At, 0, 0); PG8_STAGE(PG8_SA(1, 1), a1 + hstep, voffA);
            PG8_WAIT_V(8); PG8_WAIT_L(0); PG8_BAR; PG8_MMA(0, 0, At, B0); PG8_MMA(0, 1, At, B1); PG8_BAR; PG8_SCHED;
            PG8_LDA(At, 0, 1); PG8_STAGE(PG8_SB(0, 0), b2, voffB); PG8_STAGE(PG8_SB(0, 1), b2 + bstep, voffB); PG8_STAGE(PG8_SA(0, 0), a2, voffA);
            PG8_WAIT_V(8); PG8_WAIT_L(0); PG8_BAR; PG8_MMA(1, 0, At, B0); PG8_MMA(1, 1, At, B1); PG8_BAR; PG8_SCHED;
            PG8_LDB(B0, 1, 0); PG8_LDB(B1, 1, 1); PG8_SCHED; PG8_LDA(At, 1, 0); PG8_STAGE(PG8_SA(0, 1), a2 + hstep, voffA);
            PG8_WAIT_V(8); PG8_WAIT_L(0); PG8_BAR; PG8_MMA(0, 0, At, B0); PG8_MMA(0, 1, At, B1); PG8_BAR; PG8_SCHED;
            PG8_LDA(At, 1, 1); PG8_STAGE(PG8_SB(1, 0), b3, voffB); PG8_STAGE(PG8_SB(1, 1), b3 + bstep, voffB); PG8_STAGE(PG8_SA(1, 0), a3, voffA);
            PG8_WAIT_V(8); PG8_WAIT_L(0); PG8_BAR; PG8_MMA(1, 0, At, B0); PG8_MMA(1, 1, At, B1); PG8_BAR; PG8_SCHED;
            } else {
            PG8_LDB(B0, 0, 0); PG8_SCHED; PG8_LDA(At, 0, 0); PG8_STAGE(PG8_SA(1, 1), a1 + hstep, voffA);
            PG8_WAIT_L(8); PG8_BAR; PG8_WAIT_L(0); PG8_MMA(0, 0, At, B0); PG8_BAR; PG8_SCHED;
            PG8_LDB(B1, 0, 1); PG8_STAGE(PG8_SB(0, 0), b2, voffB);
            PG8_BAR; PG8_WAIT_L(0); PG8_MMA(0, 1, At, B1); PG8_BAR;
            PG8_LDA(At, 0, 1); PG8_STAGE(PG8_SA(0, 0), a2, voffA);
            PG8_BAR; PG8_WAIT_L(0); PG8_MMA(1, 0, At, B0); PG8_BAR; PG8_SCHED;
            PG8_STAGE(PG8_SB(0, 1), b2 + bstep, voffB);
            PG8_WAIT_V(6); PG8_BAR; PG8_MMA(1, 1, At, B1); PG8_BAR;
            PG8_LDB(B0, 1, 0); PG8_SCHED; PG8_LDA(At, 1, 0); PG8_STAGE(PG8_SA(0, 1), a2 + hstep, voffA);
            PG8_WAIT_L(8); PG8_BAR; PG8_WAIT_L(0); PG8_MMA(0, 0, At, B0); PG8_BAR; PG8_SCHED;
            PG8_LDB(B1, 1, 1); PG8_STAGE(PG8_SB(1, 0), b3, voffB);
            PG8_BAR; PG8_WAIT_L(0); PG8_MMA(0, 1, At, B1); PG8_BAR;
            PG8_LDA(At, 1, 1); PG8_STAGE(PG8_SA(1, 0), a3, voffA);
            PG8_BAR; PG8_WAIT_L(0); PG8_MMA(1, 0, At, B0); PG8_BAR; PG8_SCHED;
            PG8_STAGE(PG8_SB(1, 1), b3 + bstep, voffB);
            PG8_WAIT_V(6); PG8_BAR; PG8_MMA(1, 1, At, B1); PG8_BAR;
            }
        }
        if constexpr (ALIGN_EPI) { if (wr == 0) PG8_BAR; }
        if constexpr (!Epi::AFTER_DRAIN) { E(acc, cur, wr, wc, fr, fq); S.done(cur); }
        if (!has_next) break;
#pragma unroll
        for (int a = 0; a < 2; ++a)
#pragma unroll
            for (int b = 0; b < 2; ++b)
#pragma unroll
                for (int m = 0; m < 4; ++m)
#pragma unroll
                    for (int n = 0; n < 2; ++n) acc[a][b][m][n] = (f32x4){0.f, 0.f, 0.f, 0.f};
        cur = nxt; cA = nA; cB = nB; ++ui;
        PG8_LANE_OFFS();
        if constexpr (ALIGN_EPI) { if (wr == 1) PG8_BAR; }
    }
    PG8_WAIT_V(0);
    if constexpr (!ALIGN_EPI) { if (wr == 0) PG8_BAR; }
    PG8_BAR;
    if constexpr (Epi::AFTER_DRAIN) { E.fused(acc, cur, wr, wc, fr, fq, lds, wid, lane); S.done(cur); }
#undef PG8_LANE_OFFS
#undef PG8_SA
#undef PG8_SB
#undef PG8_STAGE
#undef PG8_LDA
#undef PG8_LDB
#undef PG8_MMA
#undef PG8_WAIT_V
#undef PG8_WAIT_L
#undef PG8_BAR
#undef PG8_SCHED
}
}

constexpr size_t MiB = 1u << 20;
constexpr size_t WS_CTL = 0, CTL_ZERO_BYTES = 65536;
constexpr size_t WS_WIN = 1 * MiB;
constexpr size_t WS_WOUT = 17 * MiB;
constexpr size_t WS_MOD = 21 * MiB;
constexpr size_t WS_ROPE = 22 * MiB;
constexpr size_t WS_KM = 24 * MiB;
constexpr size_t WS_LSE = 25 * MiB;
constexpr size_t WS_QKV = 32 * MiB;
constexpr size_t WS_Y = 32 * MiB;
constexpr size_t WS_OP = 288 * MiB;
constexpr size_t WS_H = 288 * MiB;
constexpr size_t WS_MIX = 384 * MiB;
constexpr size_t WS_X1B = 448 * MiB;
constexpr size_t WS_END = 512 * MiB;
constexpr int CW_RANK = 8192;
constexpr int CW_BAR = 4096;

#ifndef REP_P3A
#define REP_P3A 1
#endif
#ifndef REP_P3B
#define REP_P3B 1
#endif
#ifndef REP_P2
#define REP_P2 1
#endif
#ifndef REP_P4
#define REP_P4 1
#endif
#ifndef REP_P5
#define REP_P5 1
#endif
#ifndef REP_P0
#define REP_P0 1
#endif
#ifndef REP_P1
#define REP_P1 1
#endif
#ifndef REP_MOBA
#define REP_MOBA 1
#endif
constexpr int NWAVES = 8;
constexpr int RING_BYTES = 139264, LDSCTL_OFF = RING_BYTES, MISC_OFF = LDSCTL_OFF + 320, EPI_OFF = MISC_OFF + 192, LDS_BYTES = EPI_OFF + 8 * 16 * 144;

#define GAS __attribute__((address_space(1)))
#define LAS __attribute__((address_space(3)))
typedef unsigned short bf16;
typedef unsigned v4u __attribute__((ext_vector_type(4)));
typedef unsigned v2u __attribute__((ext_vector_type(2)));
typedef float f32x4 __attribute__((ext_vector_type(4)));
typedef float f32x16 __attribute__((ext_vector_type(16)));
typedef short bf16x8 __attribute__((ext_vector_type(8)));
typedef short s16x4 __attribute__((ext_vector_type(4)));
typedef GAS unsigned gu32;
#define LDS_WAIT() asm volatile("s_waitcnt lgkmcnt(0)" ::: "memory")
#define VM_WAIT() asm volatile("s_waitcnt vmcnt(0)" ::: "memory")
__device__ __forceinline__ unsigned f2bf(float f) { unsigned u = __builtin_bit_cast(unsigned, f); return (u + 0x7fffu + ((u >> 16) & 1u)) >> 16; }
typedef float f32x2_g __attribute__((ext_vector_type(2))); typedef __bf16 bf16x2_g __attribute__((ext_vector_type(2)));
__device__ __forceinline__ unsigned pk2(float lo, float hi) { f32x2_g v = {lo, hi}; bf16x2_g b = __builtin_convertvector(v, bf16x2_g); return __builtin_bit_cast(unsigned, b); }
__device__ __forceinline__ float bflo(unsigned w) { return __builtin_bit_cast(float, w << 16); }
__device__ __forceinline__ float bfhi(unsigned w) { return __builtin_bit_cast(float, w & 0xffff0000u); }

#define XB_TMO      128
#define XB_XCNT(j)  (256  + 64 * (j))
#define XB_XSUB(j)  (1280 + 64 * (j))
#define XB_XGEN(j)  (2304 + 64 * (j))
#define XB_TOP      3328
#define XB_TOPGEN   3392
#define XCD_BAR_WORDS 3456
#define XB_SPIN_CAP (1u << 18)

__device__ __forceinline__ unsigned xb_ld(unsigned* p)              { return __hip_atomic_load(p, __ATOMIC_RELAXED, __HIP_MEMORY_SCOPE_AGENT); }
__device__ __forceinline__ unsigned xb_add(unsigned* p, unsigned v) { return __hip_atomic_fetch_add(p, v, __ATOMIC_RELAXED, __HIP_MEMORY_SCOPE_AGENT); }
__device__ __forceinline__ unsigned xb_xcc_id() { return (unsigned)__builtin_amdgcn_s_getreg((3 << 11) | 20) & 0xFu; }
#define XB_SPIN(cond, bar) do { unsigned _sp = 0; while (cond) { __builtin_amdgcn_s_sleep(1); \
    if ((++_sp & 255u) == 0u) { if (xb_ld(&(bar)[XB_TMO])) break; if (_sp > XB_SPIN_CAP) { atomicAdd(&(bar)[XB_TMO], 1u); break; } } } } while (0)

struct XcdBarrier {
    unsigned* bar; unsigned x;
    volatile LAS unsigned* st;
};

__device__ __forceinline__ XcdBarrier xcd_barrier_post(unsigned* bar, volatile LAS unsigned* st) {
    XcdBarrier b; b.bar = bar; b.x = xb_xcc_id(); b.st = st;
    if (threadIdx.x == 0) (void)xb_add(&bar[XB_XCNT(b.x)], 1u);
    return b;
}
__device__ __forceinline__ void xcd_barrier_complete(unsigned* bar, unsigned x, unsigned& nloc, unsigned& nx) {
    const unsigned G = gridDim.x * gridDim.y * gridDim.z;
    unsigned sum, cnt, mine, sp = 0u;
    for (;;) {
        sum = 0u; cnt = 0u; mine = 0u;
#pragma unroll
        for (unsigned j = 0; j < 16; ++j) { const unsigned c = xb_ld(&bar[XB_XCNT(j)]); sum += c; cnt += (c > 0u) ? 1u : 0u; mine = (j == x) ? c : mine; }
        if (sum == G) break;
        __builtin_amdgcn_s_sleep(1);
        if ((++sp & 255u) == 0u) { if (xb_ld(&bar[XB_TMO])) break; if (sp > XB_SPIN_CAP) { atomicAdd(&bar[XB_TMO], 1u); break; } }
    }
    nloc = mine > 0u ? mine : 1u; nx = cnt > 0u ? cnt : 1u;
}

__device__ __forceinline__ void xcd_barrier(const XcdBarrier& b) {
    asm volatile("s_waitcnt vmcnt(0)" ::: "memory");
    __syncthreads();
    if (threadIdx.x == 0) {
        unsigned* bar = b.bar;
        __builtin_amdgcn_s_waitcnt(0);
        unsigned nloc = b.st[0], nx = b.st[1];
        if (nloc == 0u) { xcd_barrier_complete(bar, b.x, nloc, nx); b.st[0] = nloc; b.st[1] = nx; }
        const unsigned old = xb_add(&bar[XB_XSUB(b.x)], 1u);
        const unsigned gen = old / nloc;
        if (old + 1u == (gen + 1u) * nloc) {
            __builtin_amdgcn_fence(__ATOMIC_RELEASE, "agent");
            asm volatile("s_waitcnt vmcnt(0)" ::: "memory");
            const unsigned og = xb_add(&bar[XB_TOP], 1u);
            const unsigned tg = og / nx;
            if (og + 1u == (tg + 1u) * nx) xb_add(&bar[XB_TOPGEN], 1u);
            else XB_SPIN(xb_ld(&bar[XB_TOPGEN]) == tg, bar);
            __builtin_amdgcn_fence(__ATOMIC_ACQUIRE, "agent");
            xb_add(&bar[XB_XGEN(b.x)], 1u);
            asm volatile("s_waitcnt vmcnt(0)" ::: "memory");
        } else {
            XB_SPIN(xb_ld(&bar[XB_XGEN(b.x)]) == gen, bar);
            __builtin_amdgcn_fence(__ATOMIC_ACQUIRE, "agent");
            asm volatile("s_waitcnt vmcnt(0)" ::: "memory");
        }
    }
    __syncthreads();
}


__device__ __forceinline__ float wave_sum(float v) {
#pragma unroll
    for (int o = 1; o < 64; o <<= 1) v += __shfl_xor(v, o);
    return v;
}
__device__ __forceinline__ void p0_transpose_item(const float* W, int K, int N, bf16* WT, int row_off, LAS float* scr, int item, int lane) {
    const int nblk = N / 32, kb = item / nblk, nb = item % nblk, k0 = 64 * kb, n0 = 32 * nb;
#pragma unroll 8
    for (int i = 0; i < 32; ++i) { const int kk = 2 * i + (lane >> 5); scr[kk * 33 + (lane & 31)] = __builtin_nontemporal_load(W + (size_t)(k0 + kk) * N + n0 + (lane & 31)); }
    LDS_WAIT(); asm volatile("" ::: "memory");
    const int c = lane & 7;
#pragma unroll
    for (int j = 0; j < 4; ++j) { const int n = (lane >> 3) + 8 * j; const LAS float* s = scr + (8 * c) * 33 + n;
        v4u o; o.x = pk2(s[0 * 33], s[1 * 33]); o.y = pk2(s[2 * 33], s[3 * 33]); o.z = pk2(s[4 * 33], s[5 * 33]); o.w = pk2(s[6 * 33], s[7 * 33]);
        *(GAS v4u*)(WT + (size_t)(row_off + n0 + n) * K + k0 + 8 * c) = o; }
    LDS_WAIT(); asm volatile("" ::: "memory");
}


namespace att3 {
constexpr int K_OFF = 0, V_OFF = 49152, WQ_OFF = 98304, WQ_B = 4608, WSC_OFF = WQ_OFF + 8 * WQ_B;
static_assert(WSC_OFF + 8 * 512 <= LDSCTL_OFF, "attention LDS map below the control words");
__device__ __forceinline__ int crow(int r, int hi) { return (r & 3) + 8 * (r >> 2) + 4 * hi; }
__device__ __forceinline__ void glds16(const void* gsrc, unsigned lds_dst) { unsigned keep;
    asm volatile("s_mov_b32 %0, m0\n\ts_mov_b32 m0, %2\n\ts_nop 0\n\tglobal_load_lds_dwordx4 %1, off\n\ts_mov_b32 m0, %0" : "=&s"(keep) : "v"(gsrc), "s"(lds_dst) : "memory"); }
__device__ __forceinline__ void glds16nt(const void* gsrc, unsigned lds_dst) { unsigned keep;
    asm volatile("s_mov_b32 %0, m0\n\ts_mov_b32 m0, %2\n\ts_nop 0\n\tglobal_load_lds_dwordx4 %1, off nt\n\ts_mov_b32 m0, %0" : "=&s"(keep) : "v"(gsrc), "s"(lds_dst) : "memory"); }
typedef float f32x2_t __attribute__((ext_vector_type(2))); typedef __bf16 bf16x2_t __attribute__((ext_vector_type(2)));
__device__ __forceinline__ unsigned cvtpk(float lo, float hi) { f32x2_t v = {lo, hi}; bf16x2_t b = __builtin_convertvector(v, bf16x2_t); return __builtin_bit_cast(unsigned, b); }
typedef short v4i16_t __attribute__((ext_vector_type(4)));
typedef LAS const char* lds_cptr;
__device__ __forceinline__ s16x4 vtr(lds_cptr p) { return __builtin_bit_cast(s16x4, __builtin_amdgcn_ds_read_tr16_b64_v4i16((LAS v4i16_t*)p)); }
__device__ __forceinline__ float xhalf_max(float v) { auto rr = __builtin_amdgcn_permlane32_swap(__float_as_uint(v), __float_as_uint(v), false, false); return fmaxf(__uint_as_float(rr[0]), __uint_as_float(rr[1])); }
__device__ __forceinline__ float xhalf_sum(float v) { auto rr = __builtin_amdgcn_permlane32_swap(__float_as_uint(v), __float_as_uint(v), false, false); return __uint_as_float(rr[0]) + __uint_as_float(rr[1]); }
#define MFMA32(a, b, c) __builtin_amdgcn_mfma_f32_32x32x16_bf16(a, b, c, 0, 0, 0)
#define BAR() asm volatile("s_waitcnt lgkmcnt(0)\n\ts_barrier" ::: "memory")
#define WAITV_BAR(N) asm volatile("s_waitcnt vmcnt(" #N ") lgkmcnt(0)\n\ts_barrier" ::: "memory")

struct UnitA { int bh, dl, r0, m0u, two, tnew, nnew; };
__device__ __forceinline__ UnitA make_unit(int bh, int u) {
    UnitA U; U.bh = bh;
    if (u < 8) { U.dl = 0; U.r0 = 0; U.m0u = 256 * u; U.two = 0; }
    else if (u < 16) { U.dl = 2; U.r0 = (u - 8) >> 1; U.m0u = 256 * ((u - 8) & 1); U.two = 0; }
    else { U.dl = 4; U.r0 = 2 * (u - 16); U.m0u = 0; U.two = 1; }
    const int kstart = (!U.two && U.m0u >= 128) ? U.m0u - 128 : 0;
    U.tnew = kstart >> 6; U.nnew = U.two ? 4 : (U.m0u + 256 - kstart) / 64;
    return U;
}
__device__ __forceinline__ UnitA make_chain_unit(int bh, int dil4, int n) {
    UnitA U; U.bh = bh; U.two = 0;
    if (!dil4) { U.dl = 0; U.r0 = 0; U.m0u = 256 * n; U.tnew = (n == 0) ? 0 : 4 * n; U.nnew = 4; }
    else { U.dl = 2; U.r0 = n >> 1; U.m0u = 256 * (n & 1); U.tnew = (n & 1) ? 4 : 0; U.nnew = 4; }
    return U;
}
__device__ __forceinline__ int tile_tok0(const UnitA& U, int t) { return U.two ? ((64 * (t & 1)) << U.dl) + U.r0 + (t >> 1) : ((64 * t) << U.dl) + U.r0; }
__device__ __forceinline__ int slot_of(int t) { return t % 6; }
__device__ __forceinline__ void dma_k(const UnitA& U, const bf16* KA, unsigned lds0, int wid, int lane) {
    const bf16* Kh = KA + (size_t)U.bh * SEQ * 64; const int st = 1 << U.dl;
    const int krow = 8 * wid + (lane >> 3), kch = (lane & 7) ^ ((krow >> 1) & 7);
    if (U.two) { for (int i = 0; i < U.nnew; ++i) { const int t = U.tnew + i; glds16nt(Kh + (size_t)(tile_tok0(U, t) + krow * st) * 64 + kch * 8, (unsigned)__builtin_amdgcn_readfirstlane(lds0 + K_OFF + slot_of(t) * 8192 + wid * 1024)); } }
    else { for (int i = 0; i < U.nnew; ++i) { const int t = U.tnew + i; glds16(Kh + (size_t)(tile_tok0(U, t) + krow * st) * 64 + kch * 8, (unsigned)__builtin_amdgcn_readfirstlane(lds0 + K_OFF + slot_of(t) * 8192 + wid * 1024)); } }
}
__device__ __forceinline__ void dma_v(const UnitA& U, const bf16* VA, unsigned lds0, int wid, int lane) {
    const bf16* Vh = VA + (size_t)U.bh * SEQ * 64; const int st = 1 << U.dl;
    if (U.two) { for (int i = 0; i < U.nnew; ++i) { const int t = U.tnew + i; glds16nt(Vh + (size_t)(tile_tok0(U, t) + (16 * (wid & 3) + (lane >> 2)) * st) * 64 + (wid >> 2) * 32 + (lane & 3) * 8, (unsigned)__builtin_amdgcn_readfirstlane(lds0 + V_OFF + slot_of(t) * 8192 + wid * 1024)); } }
    else { for (int i = 0; i < U.nnew; ++i) { const int t = U.tnew + i; glds16(Vh + (size_t)(tile_tok0(U, t) + (16 * (wid & 3) + (lane >> 2)) * st) * 64 + (wid >> 2) * 32 + (lane & 3) * 8, (unsigned)__builtin_amdgcn_readfirstlane(lds0 + V_OFF + slot_of(t) * 8192 + wid * 1024)); } }
}
__device__ __forceinline__ void wave_geom(const UnitA& U, int wid, int& cls, int& mq0) { cls = U.two ? (wid >> 2) : 0; mq0 = U.two ? 32 * (wid & 3) : U.m0u + 32 * wid; }
__device__ __forceinline__ void dma_q(const UnitA& U, const bf16* QA, unsigned lds0, int wid, int lane) {
    int cls, mq0; wave_geom(U, wid, cls, mq0);
#pragma unroll
    for (int i = 0; i < 4; ++i) { const int row = 8 * i + (lane >> 3), ch = (lane & 7) ^ ((row >> 1) & 7);
        glds16nt(QA + ((size_t)U.bh * SEQ + (((mq0 + row) << U.dl) + U.r0 + cls)) * 64 + ch * 8, (unsigned)__builtin_amdgcn_readfirstlane(lds0 + WQ_OFF + wid * WQ_B + i * 1024)); }
}

template <bool FINAL, class UnitFn>
__device__ __forceinline__ void run_units(int n_units, UnitFn unit_of, const bf16* QA, const bf16* KA, const bf16* VA, const bf16* GA, bf16* OP, float* LSE, bf16* MIX, LAS char* lds) {
    int tid_o = threadIdx.x; asm volatile("" : "+v"(tid_o));
    const int lane = tid_o & 63, wid = __builtin_amdgcn_readfirstlane(tid_o >> 6);
    const int r32 = lane & 31, hi = lane >> 5;
    const unsigned lds0 = (unsigned)(size_t)lds;
    UnitA U = unit_of(0);
    dma_q(U, QA, lds0, wid, lane); dma_k(U, KA, lds0, wid, lane); dma_v(U, VA, lds0, wid, lane);
    for (int n = 0; n < n_units; ++n) {
        const bool has_next = n + 1 < n_units;
        UnitA UN = U; if (has_next) UN = unit_of(n + 1);
        int cls, mq0; wave_geom(U, wid, cls, mq0);
        if (U.nnew == 6) WAITV_BAR(6); else WAITV_BAR(4);
        const lds_cptr wq = (lds_cptr)lds + WQ_OFF + wid * WQ_B;
        bf16x8 qr[4];
#pragma unroll
        for (int d0 = 0; d0 < 4; ++d0) qr[d0] = *(const LAS bf16x8*)(wq + r32 * 128 + (((2 * d0 + hi) ^ ((r32 >> 1) & 7)) << 4));
        const int gg0 = U.two ? 4 * cls + (mq0 >> 5) : (mq0 >> 5);
        const int ng = (mq0 >> 5) < 4 ? (mq0 >> 5) + 1 : 5;
        f32x16 S[5];
#pragma unroll
        for (int g = 0; g < 5; ++g) {
            f32x16 acc; float ini = (g < ng) ? 0.f : -INFINITY; asm volatile("" : "+v"(ini));
#pragma unroll
            for (int r = 0; r < 16; ++r) acc[r] = ini;
            asm volatile("" : "+v"(acc));
            {
                const int gg = (g < ng) ? gg0 - g : gg0;
                const lds_cptr kp = (lds_cptr)lds + K_OFF + slot_of(gg >> 1) * 8192 + ((gg & 1) * 32 + r32) * 128;
#pragma unroll
                for (int d0 = 0; d0 < 4; ++d0) acc = MFMA32(*(const LAS bf16x8*)(kp + (((2 * d0 + hi) ^ ((r32 >> 1) & 7)) << 4)), qr[d0], acc);
            }
            S[g] = acc;
        }
        const float NINF = -INFINITY;
#pragma unroll
        for (int r = 0; r < 16; ++r) { if (crow(r, hi) > r32) S[0][r] = NINF; }
#pragma unroll
        for (int r = 0; r < 16; ++r) { if (crow(r, hi) < r32) S[4][r] = NINF; }
        BAR();
        const int dl = U.dl, rc = U.r0 + cls, bh = U.bh;
        const int qtok = ((mq0 + r32) << dl) + rc;
        float la = 0.f, lb = 0.f; v4u a0[4], a1[4], gq[4];
        if (FINAL) {
            const size_t q = (size_t)bh * SEQ + qtok;
            la = LSE[q]; lb = LSE[(size_t)128 * SEQ + q];
#pragma unroll
            for (int i = 0; i < 4; ++i) { const int row = i * 8 + (lane >> 3), ch = lane & 7;
                const size_t qq = (size_t)bh * SEQ + (((mq0 + row) << dl) + rc);
                a0[i] = __builtin_nontemporal_load((const v4u*)(OP + qq * 64 + ch * 8)); a1[i] = __builtin_nontemporal_load((const v4u*)(OP + ((size_t)128 * SEQ + qq) * 64 + ch * 8)); gq[i] = __builtin_nontemporal_load((const v4u*)(GA + qq * 64 + ch * 8)); }
        }
        if (has_next) { dma_k(UN, KA, lds0, wid, lane); dma_q(UN, QA, lds0, wid, lane); }
        float rm = S[0][0];
#pragma unroll
        for (int r = 1; r < 16; ++r) rm = fmaxf(rm, S[0][r]);
#pragma unroll
        for (int g = 1; g < 5; ++g) {
#pragma unroll
            for (int r = 0; r < 16; ++r) rm = fmaxf(rm, S[g][r]); }
        const float m = xhalf_max(rm);
        float l0 = 0.f, l1 = 0.f;
        v4u P[5][2];
#pragma unroll
        for (int g = 0; g < 5; ++g) {
#pragma unroll
            for (int r = 0; r < 16; ++r) S[g][r] = __builtin_amdgcn_exp2f(S[g][r] - m);
#pragma unroll
            for (int r = 0; r < 16; r += 2) { l0 += S[g][r]; l1 += S[g][r + 1]; }
            P[g][0].x = cvtpk(S[g][0], S[g][1]); P[g][0].y = cvtpk(S[g][2], S[g][3]); P[g][0].z = cvtpk(S[g][4], S[g][5]); P[g][0].w = cvtpk(S[g][6], S[g][7]);
            P[g][1].x = cvtpk(S[g][8], S[g][9]); P[g][1].y = cvtpk(S[g][10], S[g][11]); P[g][1].z = cvtpk(S[g][12], S[g][13]); P[g][1].w = cvtpk(S[g][14], S[g][15]);
        }
        if (!has_next) WAITV_BAR(0); else if (UN.nnew == 6) WAITV_BAR(10); else WAITV_BAR(8);
        f32x16 o0, o1; { float zf = 0.f; asm volatile("" : "+v"(zf));
#pragma unroll
          for (int r = 0; r < 16; ++r) { o0[r] = zf; o1[r] = zf; } } asm volatile("" : "+v"(o0), "+v"(o1));
#pragma unroll
        for (int g = 0; g < 5; ++g) {
            const int gg = (g < ng) ? gg0 - g : gg0;
            const lds_cptr vp = (lds_cptr)lds + V_OFF + slot_of(gg >> 1) * 8192 + (2 * (gg & 1)) * 1024 + ((lane >> 4) & 1) * 32 + (lane & 3) * 8 + (4 * hi + ((lane & 15) >> 2)) * 64;
#define VF(off) ({ const s16x4 lo_ = vtr(vp + (off)); const s16x4 hi_ = vtr(vp + (off) + 512); (bf16x8){lo_[0], lo_[1], lo_[2], lo_[3], hi_[0], hi_[1], hi_[2], hi_[3]}; })
            const bf16x8 pf0 = __builtin_bit_cast(bf16x8, P[g][0]), pf1 = __builtin_bit_cast(bf16x8, P[g][1]);
            o0 = MFMA32(VF(0), pf0, o0); o1 = MFMA32(VF(4096), pf0, o1);
            o0 = MFMA32(VF(1024), pf1, o0); o1 = MFMA32(VF(4096 + 1024), pf1, o1);
#undef VF
        }
        BAR();
        const float lt = xhalf_sum(l0 + l1), inv = 1.f / lt;
        const float lse = m + __builtin_amdgcn_logf(lt);
        if (!FINAL) {
            const size_t pb = (size_t)((dl >> 1) * 128 + bh) * SEQ;
            if (hi == 0) LSE[pb + qtok] = lse;
            LAS char* stg = lds + V_OFF + wid * WQ_B;
#pragma unroll
            for (int dh = 0; dh < 2; ++dh)
#pragma unroll
                for (int rq = 0; rq < 4; ++rq) { const f32x16& o = dh ? o1 : o0;
                    v2u w; w.x = cvtpk(o[4 * rq] * inv, o[4 * rq + 1] * inv); w.y = cvtpk(o[4 * rq + 2] * inv, o[4 * rq + 3] * inv);
                    *(LAS v2u*)(stg + r32 * 144 + (32 * dh + 8 * rq + 4 * hi) * 2) = w; }
#pragma unroll
            for (int i = 0; i < 4; ++i) { const int row = i * 8 + (lane >> 3), ch = lane & 7;
                const v4u v = *(const LAS v4u*)(stg + row * 144 + ch * 16);
                __builtin_nontemporal_store(v, (v4u*)(OP + (pb + ((mq0 + row) << dl) + rc) * 64 + ch * 8)); }
            BAR();
            if (has_next) dma_v(UN, VA, lds0, wid, lane);
        } else {
            LAS char* stg = lds + V_OFF + wid * WQ_B;
#pragma unroll
            for (int dh = 0; dh < 2; ++dh)
#pragma unroll
                for (int rq = 0; rq < 4; ++rq) { const f32x16& o = dh ? o1 : o0;
                    v2u w; w.x = cvtpk(o[4 * rq] * inv, o[4 * rq + 1] * inv); w.y = cvtpk(o[4 * rq + 2] * inv, o[4 * rq + 3] * inv);
                    *(LAS v2u*)(stg + r32 * 144 + (32 * dh + 8 * rq + 4 * hi) * 2) = w; }
            LAS float* wsc = (LAS float*)(lds + WSC_OFF) + wid * 128;
            const float mx = fmaxf(lse, fmaxf(la, lb));
            const float w0 = __builtin_amdgcn_exp2f(la - mx), w1 = __builtin_amdgcn_exp2f(lb - mx), w2 = __builtin_amdgcn_exp2f(lse - mx);
            const float winv = 1.f / (w0 + w1 + w2);
            if (hi == 0) { wsc[r32 * 4 + 0] = w0 * winv; wsc[r32 * 4 + 1] = w1 * winv; wsc[r32 * 4 + 2] = w2 * winv; }
            const int b = bh >> 3, h = bh & 7;
#pragma unroll
            for (int i = 0; i < 4; ++i) { const int row = i * 8 + (lane >> 3), ch = lane & 7;
                const int tok = ((mq0 + row) << dl) + rc;
                const v4u a2 = *(const LAS v4u*)(stg + row * 144 + ch * 16);
                const float x0 = wsc[row * 4 + 0], x1 = wsc[row * 4 + 1], x2 = wsc[row * 4 + 2];
                v4u o;
#define MRG(c) pk2((x0 * bflo(a0[i].c) + x1 * bflo(a1[i].c) + x2 * bflo(a2.c)) * bflo(gq[i].c), (x0 * bfhi(a0[i].c) + x1 * bfhi(a1[i].c) + x2 * bfhi(a2.c)) * bfhi(gq[i].c))
                o.x = MRG(x); o.y = MRG(y); o.z = MRG(z); o.w = MRG(w);
#undef MRG
                *(v4u*)(MIX + (size_t)(b * SEQ + tok) * DM + h * 64 + ch * 8) = o; }
            BAR();
            if (has_next) dma_v(UN, VA, lds0, wid, lane);
        }
        U = UN;
    }
    WAITV_BAR(0);
}
#undef MFMA32
#undef BAR
#undef WAITV_BAR
}

namespace attb {
using bf16=__hip_bfloat16;
using bf16x8=__attribute__((ext_vector_type(8)))short;
using s16x4=__attribute__((ext_vector_type(4)))short;
using f32x16=__attribute__((ext_vector_type(16)))float;
using u32x4=__attribute__((ext_vector_type(4)))unsigned;
typedef float f32x4g __attribute__((ext_vector_type(4)));
#define BFLO(w) __builtin_bit_cast(float,(unsigned)(w)<<16)
#define BFHI(w) __builtin_bit_cast(float,(unsigned)(w)&0xffff0000u)
constexpr int SEQ=2048,D=64,DM=64;
constexpr int NW=8,QBLK=32,QB=QBLK*NW,KVBLK=64,NQB=SEQ/QB;
__device__ __forceinline__ int crow(int r,int hi){return (r&3)+8*(r>>2)+4*hi;}
#define SBAR() __builtin_amdgcn_sched_barrier(0)
__device__ __forceinline__ void cmask(f32x16&p0,f32x16&p1,int jb,int qrel,int hi){
  const float NEG=-INFINITY; int kb=64*jb+4*hi;
  #pragma unroll
  for(int r=0;r<16;++r){int kv=kb+(r&3)+8*(r>>2); if(kv>qrel)p0[r]=NEG; if(kv+32>qrel)p1[r]=NEG;}
}

constexpr int NSLOT=3, SLOTB=8192;
constexpr int LDS_K=0, LDS_V=NSLOT*SLOTB, LDS_WS=2*NSLOT*SLOTB, LDS_OST=LDS_WS+NW*64*4, LDS_Q=LDS_OST+NW*4096, LDS_KM=LDS_Q+NW*4096, LDS_BYTES=LDS_KM+2048;
constexpr float C2=0.125f*1.4426950408889634f;
__device__ __forceinline__ void glds16(const void*gsrc,unsigned lds_dst){unsigned keep;
  asm volatile("s_mov_b32 %0, m0\n\ts_mov_b32 m0, %2\n\ts_nop 0\n\tglobal_load_lds_dwordx4 %1, off\n\ts_mov_b32 m0, %0":"=&s"(keep):"v"(gsrc),"s"(lds_dst):"memory");}
__device__ __forceinline__ void glds16nt(const void*gsrc,unsigned lds_dst){unsigned keep;
  asm volatile("s_mov_b32 %0, m0\n\ts_mov_b32 m0, %2\n\ts_nop 0\n\tglobal_load_lds_dwordx4 %1, off nt\n\ts_mov_b32 m0, %0":"=&s"(keep):"v"(gsrc),"s"(lds_dst):"memory");}
__device__ __forceinline__ float max3f(float a,float b,float c){float r;asm("v_max3_f32 %0, %1, %2, %3":"=v"(r):"v"(a),"v"(b),"v"(c));return r;}
__device__ __forceinline__ float max2f(float a,float b){float r;asm("v_max_f32_e32 %0, %1, %2":"=v"(r):"v"(a),"v"(b));return r;}
__device__ __forceinline__ float fadd_s(float a,float b){float r;asm("v_add_f32_e32 %0, %1, %2":"=v"(r):"v"(a),"v"(b));return r;}
__device__ __forceinline__ float fsub_s(float a,float b){float r;asm("v_sub_f32_e32 %0, %1, %2":"=v"(r):"v"(a),"v"(b));return r;}
typedef float f32x2_t __attribute__((ext_vector_type(2))); typedef __bf16 bf16x2_t __attribute__((ext_vector_type(2)));
__device__ __forceinline__ unsigned cvtpk_s(float lo,float hi){f32x2_t v={lo,hi};bf16x2_t b=__builtin_convertvector(v,bf16x2_t);return __builtin_bit_cast(unsigned,b);}
#define WAIT_BAR(N) asm volatile("s_waitcnt vmcnt(" #N ") lgkmcnt(0)\n\ts_barrier":::"memory")

__device__ __forceinline__ void qkt(f32x16&p0,f32x16&p1,const char*Kslot,const bf16x8*qr,const f32x16&negm,int r32,int hi){
  const char*kb=Kslot+hi*1024+r32*16;
  #pragma unroll
  for(int d0=0;d0<4;++d0){
    const bf16x8 b0=*reinterpret_cast<const bf16x8*>(kb+d0*2048);
    const bf16x8 b1=*reinterpret_cast<const bf16x8*>(kb+d0*2048+512);
    if(d0==0){p0=__builtin_amdgcn_mfma_f32_32x32x16_bf16(b0,qr[0],negm,0,0,0);p1=__builtin_amdgcn_mfma_f32_32x32x16_bf16(b1,qr[0],negm,0,0,0);}
    else{p0=__builtin_amdgcn_mfma_f32_32x32x16_bf16(b0,qr[d0],p0,0,0,0);p1=__builtin_amdgcn_mfma_f32_32x32x16_bf16(b1,qr[d0],p1,0,0,0);}}
}
typedef __attribute__((address_space(3))) const char* lds_cptr;
typedef short v4i16_t __attribute__((ext_vector_type(4)));
__device__ __forceinline__ void kload8(bf16x8*kf,lds_cptr kp){
  kf[0]=*(const __attribute__((address_space(3))) bf16x8*)(kp);      kf[1]=*(const __attribute__((address_space(3))) bf16x8*)(kp+512);
  kf[2]=*(const __attribute__((address_space(3))) bf16x8*)(kp+2048); kf[3]=*(const __attribute__((address_space(3))) bf16x8*)(kp+2560);
  kf[4]=*(const __attribute__((address_space(3))) bf16x8*)(kp+4096); kf[5]=*(const __attribute__((address_space(3))) bf16x8*)(kp+4608);
  kf[6]=*(const __attribute__((address_space(3))) bf16x8*)(kp+6144); kf[7]=*(const __attribute__((address_space(3))) bf16x8*)(kp+6656);
}
__device__ __forceinline__ void kload2(bf16x8*kf,lds_cptr kp,int j){ kf[2*j]=*(const __attribute__((address_space(3))) bf16x8*)(kp+j*2048); kf[2*j+1]=*(const __attribute__((address_space(3))) bf16x8*)(kp+j*2048+512); }
__device__ __forceinline__ s16x4 vtr(lds_cptr p){ return __builtin_bit_cast(s16x4,__builtin_amdgcn_ds_read_tr16_b64_v4i16((__attribute__((address_space(3))) v4i16_t*)p)); }
__device__ __forceinline__ float rowmax(const f32x16&p0,const f32x16&p1){
  float a=max3f(p0[0],p0[1],p1[0]),b=max3f(p0[2],p0[3],p1[1]);a=max3f(a,p1[2],p1[3]);
  #pragma unroll
  for(int r=4;r<16;r+=4){a=max3f(a,p0[r],p0[r+1]);b=max3f(b,p0[r+2],p0[r+3]);a=max3f(a,p1[r],p1[r+1]);b=max3f(b,p1[r+2],p1[r+3]);}
  const float m=max2f(a,b);
  auto rr=__builtin_amdgcn_permlane32_swap(__float_as_uint(m),__float_as_uint(m),false,false);
  return max2f(__uint_as_float(rr[0]),__uint_as_float(rr[1]));
}
__device__ __forceinline__ void pv(f32x16*o,int vb,bf16x8 pa0,bf16x8 pa1,bf16x8 pa2,bf16x8 pa3){
  #pragma unroll
  for(int d0=0;d0<2;++d0){s16x4 lo[4],hi[4];
    #pragma unroll
    for(int ks=0;ks<4;++ks){
      asm volatile("ds_read_b64_tr_b16 %0,%1 offset:%c2":"=&v"(lo[ks]):"v"(vb),"i"(d0*4096+ks*1024):"memory");
      asm volatile("ds_read_b64_tr_b16 %0,%1 offset:%c2":"=&v"(hi[ks]):"v"(vb),"i"(d0*4096+ks*1024+512):"memory");}
    asm volatile("s_waitcnt lgkmcnt(0)":::"memory");SBAR();
    #define PK(k) (bf16x8){lo[k][0],lo[k][1],lo[k][2],lo[k][3],hi[k][0],hi[k][1],hi[k][2],hi[k][3]}
    o[d0]=__builtin_amdgcn_mfma_f32_32x32x16_bf16(pa0,PK(0),o[d0],0,0,0);
    o[d0]=__builtin_amdgcn_mfma_f32_32x32x16_bf16(pa1,PK(1),o[d0],0,0,0);
    o[d0]=__builtin_amdgcn_mfma_f32_32x32x16_bf16(pa2,PK(2),o[d0],0,0,0);
    o[d0]=__builtin_amdgcn_mfma_f32_32x32x16_bf16(pa3,PK(3),o[d0],0,0,0);
    #undef PK
  }
}

#ifndef ATTN_STORE16
#define ATTN_STORE16(p,v) (*(u32x4*)(p)=(v))
#endif
template<int THRL> __device__ __forceinline__ void moba_unit(int bh,int j,const bf16*Q,const bf16*__restrict__ K,const bf16*__restrict__ V,const unsigned short*G,const float*KM,unsigned short*MIX,char*shm,bool pre,int nbh,int nj){
  int tid_o=threadIdx.x; asm volatile("":"+v"(tid_o)); const int tid=tid_o,lane=tid&63,r32=lane&31,hi=lane>>5; const int wid=__builtin_amdgcn_readfirstlane(tid>>6);
  const long rowbase=(long)bh*SEQ; const int q0=j*QB;
  const bf16*Qw=Q+(rowbase+q0+wid*QBLK)*DM;
  const bf16*Kh=K+rowbase*DM,*Vh=V+rowbase*DM;
  const unsigned lds0=(unsigned)(uintptr_t)shm;
  float*wsf=(float*)(shm+LDS_WS)+wid*64;
  const bf16*ksrc=Kh+(long)lane*DM+wid*8;
  const bf16*vsrc=Vh+(long)(16*(wid&3)+(lane>>2))*DM+(wid>>2)*32+(lane&3)*8;
  const unsigned kdst=lds0+LDS_K+wid*1024, vdst=lds0+LDS_V+wid*1024;
  #define TROW(t) ((t)<4 ? q0+KVBLK*(t) : KVBLK*((t)-4))
  #define DMA_K(t,slot) glds16(ksrc+(long)TROW(t)*DM,(unsigned)__builtin_amdgcn_readfirstlane(kdst+(slot)))
  #define DMA_V(t,slot) glds16(vsrc+(long)TROW(t)*DM,(unsigned)__builtin_amdgcn_readfirstlane(vdst+(slot)))
  const int vb0=(int)(lds0+LDS_V)+((lane>>4)&1)*32+(lane&3)*8+(4*hi+((lane&15)>>2))*64;
  const char*Kbase=shm+LDS_K; bf16x8 kf[8];
  const lds_cptr shm3=(lds_cptr)shm; const lds_cptr qlp=shm3+LDS_Q+wid*4096+(hi*32+r32)*16;
  #define QL(d0) (*(const __attribute__((address_space(3))) bf16x8*)(qlp+(d0)*1024))
  const lds_cptr kp0=shm3+LDS_K+hi*1024+r32*16; const lds_cptr vp0=shm3+LDS_V+((lane>>4)&1)*32+(lane&3)*8+(4*hi+((lane&15)>>2))*64;
  const int NT=4+4*j;
  { const bf16*qsrc=Qw+(long)(lane&31)*DM+(lane>>5)*8; const unsigned qdst=lds0+LDS_Q+wid*4096;
    if(!pre){ _Pragma("unroll") for(int i=0;i<4;++i) glds16nt(qsrc+i*16,(unsigned)__builtin_amdgcn_readfirstlane(qdst+i*1024)); }
    const unsigned short*gsrc=G+(rowbase+q0+wid*QBLK+(lane>>3))*DM+(lane&7)*8; const unsigned gdst=lds0+LDS_OST+wid*4096;
    _Pragma("unroll") for(int i=0;i<4;++i) glds16nt(gsrc+(long)i*8*DM,(unsigned)__builtin_amdgcn_readfirstlane(gdst+i*1024));
    if(!pre&&wid<2) glds16(KM+(size_t)bh*512+wid*256+lane*4,(unsigned)__builtin_amdgcn_readfirstlane(lds0+LDS_KM+wid*1024)); }
  if(!pre){DMA_K(0,0);} DMA_V(0,0); if(!pre){DMA_K(1,SLOTB);}
  float mhat=0.f,l_reg=0.f,msk=0.f;f32x16 o[2];{ float zf_=0.f; asm volatile("":"+v"(zf_)); _Pragma("unroll") for(int r=0;r<16;++r){o[0][r]=zf_;o[1][r]=zf_;} } asm volatile("":"+v"(o[0]),"+v"(o[1]));    float nmv=0.f;
  const int qrel=wid*QBLK+r32;
  #define CMASK(P0,P1,t) do{ if((t)<4) cmask(P0,P1,(t),qrel,hi); }while(0)
  bool resc=false;
  #define START(P0,P1) do{ const float rm=rowmax(P0,P1); resc=false; \
    { const float dl=rm; mhat=fadd_s(mhat,dl); \
      _Pragma("unroll") for(int r=0;r<16;++r){P0[r]=fsub_s(P0[r],dl);P1[r]=fsub_s(P1[r],dl);} \
      nmv=-mhat; } \
    _Pragma("unroll") for(int r=0;r<16;++r)P0[r]=__builtin_amdgcn_exp2f(P0[r]); }while(0)
  #define RESC() do{ if(resc){ asm volatile("s_waitcnt lgkmcnt(0)":::"memory"); \
      _Pragma("unroll") for(int d_=0;d_<2;++d_) _Pragma("unroll") for(int r=0;r<16;++r)o[d_][r]*=wsf[crow(r,hi)]; } }while(0)
  f32x16 pA0,pA1,pB0,pB1;
  int sl_prev=0,sl_cur=0,sl_next=SLOTB;
  #define ROT() do{sl_prev=sl_cur;sl_cur=sl_next;sl_next=(sl_next==(NSLOT-1)*SLOTB)?0:sl_next+SLOTB;}while(0)
  if(!pre){ DMA_K(2,2*SLOTB);
    WAIT_BAR(3); }
  else { WAIT_BAR(9); }
  bf16x8 ql_[4]; _Pragma("unroll") for(int d0=0;d0<4;++d0)ql_[d0]=QL(d0);
  unsigned sel=0u;
  if(j<=3) sel=(1u<<j)-1u;
  else{
    float g[7];
    const __attribute__((address_space(3))) float*kmb=(const __attribute__((address_space(3))) float*)(shm3+LDS_KM)+hi*8;
    #pragma unroll
    for(int n=0;n<7;++n){ float acc=0.f;
      if(n<j){
        #pragma unroll
        for(int d0=0;d0<4;++d0){ const f32x4g k0=*(const __attribute__((address_space(3))) f32x4g*)(kmb+n*64+d0*16),k1=*(const __attribute__((address_space(3))) f32x4g*)(kmb+n*64+d0*16+4);
          const u32x4 qw=__builtin_bit_cast(u32x4,ql_[d0]);
          acc+=BFLO(qw.x)*k0[0]+BFHI(qw.x)*k0[1]+BFLO(qw.y)*k0[2]+BFHI(qw.y)*k0[3]+BFLO(qw.z)*k1[0]+BFHI(qw.z)*k1[1]+BFLO(qw.w)*k1[2]+BFHI(qw.w)*k1[3]; }
        { auto rr=__builtin_amdgcn_permlane32_swap(__float_as_uint(acc),__float_as_uint(acc),false,false); acc=__uint_as_float(rr[0])+__uint_as_float(rr[1]); }
      }
      g[n]=acc; }
    #pragma unroll
    for(int t_=0;t_<3;++t_){ float best=0.f; int bi=-1;
      #pragma unroll
      for(int n=0;n<7;++n){ const bool cand=(n<j)&&!((sel>>n)&1u)&&(bi<0||g[n]>best); if(cand){best=g[n];bi=n;} }
      sel|=1u<<bi; }
  }
  bf16x8 q0p;
  { f32x16 z0_; { float zf_=0.f; asm volatile("":"+v"(zf_)); _Pragma("unroll") for(int r=0;r<16;++r)z0_[r]=zf_; } asm volatile("":"+v"(z0_)); q0p=ql_[0]; qkt(pA0,pA1,Kbase,ql_,z0_,r32,hi); }asm volatile("s_nop 15\n\ts_nop 7":"+v"(pA0),"+v"(pA1));CMASK(pA0,pA1,0);
  START(pA0,pA1);
  _Pragma("unroll") for(int r=0;r<16;++r)pA1[r]=__builtin_amdgcn_exp2f(pA1[r]);
  WAIT_BAR(0);
  DMA_K(3,0);DMA_V(1,SLOTB);
  ROT();
  kload8(kf,kp0+sl_cur);
  WAIT_BAR(2);
  s16x4 vlo[8],vhi[8]; u32x4 pw0,pw1,pw2,pw3;
  #define PKW(P,B) cvtpk_s(P[B],P[B+1])
  #define PAF(k) __builtin_bit_cast(bf16x8,pw##k)
  #define VFR(i) (bf16x8){vlo[i][0],vlo[i][1],vlo[i][2],vlo[i][3],vhi[i][0],vhi[i][1],vhi[i][2],vhi[i][3]}
  #define PIN(x) asm volatile("":"+v"(x))
  #define MX3(a,b,c) __builtin_fmaxf(__builtin_fmaxf((a),(b)),(c))
  #define GAPA(MF,A0,A1,A2,A3,W0,W1,PW) do{ MF; sacc+=A0; sacc+=A1; sacc+=A2; sacc+=A3; PIN(sacc); W0; W1; PIN(PW); SBAR(); }while(0)
  #define EX(v) __builtin_amdgcn_exp2f(v)
  #define GAPB(MF,X,B) do{ MF; X[B]=EX(X[B]); X[B+1]=EX(X[B+1]); X[B+2]=EX(X[B+2]); X[B+3]=EX(X[B+3]); PIN(X); SBAR(); }while(0)
  #define VRD(i) do{ vlo[i]=vtr(vp_+(((i)>>2)*4096+((i)&3)*1024)); vhi[i]=vtr(vp_+(((i)>>2)*4096+((i)&3)*1024+512)); }while(0)
  #define KRD(G,j) do{ if(G){ kload2(kf,kp0+sl_next,j); SBAR(); } }while(0)
  #define STEP(C0,C1,P0,P1,t,GK,GV,GL) do{ SBAR(); \
    const lds_cptr vp_=vp0+sl_prev; \
    VRD(0); SBAR(); float sacc=(P0[0]+P0[1]); \
    _Pragma("unroll") for(int r_=0;r_<16;++r_)C1[r_]=nmv; PIN(C1); \
    const bf16x8 q1_=QL(1); SBAR(); \
    GAPA(C0=__builtin_amdgcn_mfma_f32_32x32x16_bf16(kf[0],q0p,C1,0,0,0), P0[2],P0[3],P0[4],P0[5],     pw0[0]=PKW(P0,0), pw0[1]=PKW(P0,2), pw0); \
    VRD(4); SBAR(); GAPA(C1=__builtin_amdgcn_mfma_f32_32x32x16_bf16(kf[1],q0p,C1,0,0,0), P0[6],P0[7],P0[8],P0[9],     pw0[2]=PKW(P0,4), pw0[3]=PKW(P0,6), pw0); \
    VRD(1); const bf16x8 q2_=QL(2); SBAR(); GAPA(C0=__builtin_amdgcn_mfma_f32_32x32x16_bf16(kf[2],q1_,C0,0,0,0),   P0[10],P0[11],P0[12],P0[13], pw1[0]=PKW(P0,8), pw1[1]=PKW(P0,10), pw1); \
    VRD(5); SBAR(); GAPA(C1=__builtin_amdgcn_mfma_f32_32x32x16_bf16(kf[3],q1_,C1,0,0,0),   P0[14],P0[15],P1[0],P1[1],   pw1[2]=PKW(P0,12),pw1[3]=PKW(P0,14), pw1); \
    VRD(2); const bf16x8 q3_=QL(3); SBAR(); GAPA(C0=__builtin_amdgcn_mfma_f32_32x32x16_bf16(kf[4],q2_,C0,0,0,0),   P1[2],P1[3],P1[4],P1[5],     pw2[0]=PKW(P1,0), pw2[1]=PKW(P1,2), pw2); \
    VRD(6); SBAR(); GAPA(C1=__builtin_amdgcn_mfma_f32_32x32x16_bf16(kf[5],q2_,C1,0,0,0),   P1[6],P1[7],P1[8],P1[9],     pw2[2]=PKW(P1,4), pw2[3]=PKW(P1,6), pw2); \
    VRD(3); SBAR(); GAPA(C0=__builtin_amdgcn_mfma_f32_32x32x16_bf16(kf[6],q3_,C0,0,0,0),   P1[10],P1[11],P1[12],P1[13], pw3[0]=PKW(P1,8), pw3[1]=PKW(P1,10), pw3); \
    VRD(7); SBAR(); GAPA(C1=__builtin_amdgcn_mfma_f32_32x32x16_bf16(kf[7],q3_,C1,0,0,0),   P1[14],P1[15],0.f,0.f,       pw3[2]=PKW(P1,12),pw3[3]=PKW(P1,14), pw3); \
    l_reg+=sacc; \
    if(GK){DMA_K((t)+3,sl_cur);} if(GV){DMA_V((t)+1,sl_next);} \
    CMASK(C0,C1,t); \
    { float a=MX3(C0[0],C0[1],C1[0]),b=MX3(C0[2],C0[3],C1[1]); a=MX3(a,C1[2],C1[3]); \
      _Pragma("unroll") for(int r=4;r<16;r+=4){a=MX3(a,C0[r],C0[r+1]);b=MX3(b,C0[r+2],C0[r+3]);a=MX3(a,C1[r],C1[r+1]);b=MX3(b,C1[r+2],C1[r+3]);} \
      float rm=__builtin_fmaxf(a,b); { auto rr=__builtin_amdgcn_permlane32_swap(__float_as_uint(rm),__float_as_uint(rm),false,false); rm=__builtin_fmaxf(__uint_as_float(rr[0]),__uint_as_float(rr[1])); } \
      resc=false; \
      if(__builtin_expect(__any(rm>(float)THRL),0)){ const float dl=__builtin_fmaxf(rm,0.f); mhat+=dl; \
        _Pragma("unroll") for(int r=0;r<16;++r){C0[r]-=dl;C1[r]-=dl;} \
        nmv=msk-mhat; \
        const float f=__builtin_amdgcn_exp2f(-dl); l_reg*=f; if(hi==0)wsf[r32]=f; resc=true; } } \
    SBAR(); \
    GAPB(o[0]=__builtin_amdgcn_mfma_f32_32x32x16_bf16(PAF(0),VFR(0),o[0],0,0,0), C0,0); \
    GAPB(o[1]=__builtin_amdgcn_mfma_f32_32x32x16_bf16(PAF(0),VFR(4),o[1],0,0,0), C0,4); \
    KRD(GL,0); GAPB(o[0]=__builtin_amdgcn_mfma_f32_32x32x16_bf16(PAF(1),VFR(1),o[0],0,0,0), C0,8); \
    KRD(GL,1); GAPB(o[1]=__builtin_amdgcn_mfma_f32_32x32x16_bf16(PAF(1),VFR(5),o[1],0,0,0), C0,12); \
    KRD(GL,2); GAPB(o[0]=__builtin_amdgcn_mfma_f32_32x32x16_bf16(PAF(2),VFR(2),o[0],0,0,0), C1,0); \
    KRD(GL,3); GAPB(o[1]=__builtin_amdgcn_mfma_f32_32x32x16_bf16(PAF(2),VFR(6),o[1],0,0,0), C1,4); \
    GAPB(o[0]=__builtin_amdgcn_mfma_f32_32x32x16_bf16(PAF(3),VFR(3),o[0],0,0,0), C1,8); \
    GAPB(o[1]=__builtin_amdgcn_mfma_f32_32x32x16_bf16(PAF(3),VFR(7),o[1],0,0,0), C1,12); \
    }while(0)
  #define ENDW(tt) do{ if((tt)+3<NT){WAIT_BAR(2);} else if((tt)+2<NT){WAIT_BAR(1);} else {WAIT_BAR(0);} }while(0)
  #define UPD(tt) do{ if(((tt)&3)==0){ const int n_=(((tt)-4)>>2)&7; msk=((sel>>n_)&1u)?0.f:-INFINITY; nmv=msk-mhat; } }while(0)
  STEP(pB0,pB1,pA0,pA1,1,(4<NT),true,true); ENDW(1); RESC(); ROT();
  int t=2;
  for(;t+5<NT;t+=2){ UPD(t);
    STEP(pA0,pA1,pB0,pB1,t,true,true,true);     WAIT_BAR(2); RESC(); ROT();
    STEP(pB0,pB1,pA0,pA1,t+1,true,true,true);   WAIT_BAR(2); RESC(); ROT();
  }
  for(;t+2<NT;t+=2){ UPD(t);
    STEP(pA0,pA1,pB0,pB1,t,(t+3<NT),true,true);               ENDW(t);   RESC(); ROT();
    STEP(pB0,pB1,pA0,pA1,t+1,(t+4<NT),(t+2<NT),(t+2<NT));     ENDW(t+1); RESC(); ROT();
  }
  UPD(t);
  STEP(pA0,pA1,pB0,pB1,t,false,true,true); ENDW(t); RESC(); ROT();
  if(nj>=0){ const bf16*nk=ksrc+((long)(nbh-bh)*SEQ+(long)nj*QB)*DM;
    glds16(nk,(unsigned)__builtin_amdgcn_readfirstlane(kdst)); glds16(nk+(long)KVBLK*DM,(unsigned)__builtin_amdgcn_readfirstlane(kdst+SLOTB)); glds16(nk+(long)2*KVBLK*DM,(unsigned)__builtin_amdgcn_readfirstlane(kdst+2*SLOTB));
    if(wid<2) glds16(KM+(size_t)nbh*512+wid*256+lane*4,(unsigned)__builtin_amdgcn_readfirstlane(lds0+LDS_KM+wid*1024)); }
  STEP(pB0,pB1,pA0,pA1,NT-1,false,false,false); RESC();
  if(nj>=0){ const bf16*nq=Q+((long)nbh*SEQ+(long)nj*QB+wid*QBLK+(lane&31))*DM+(lane>>5)*8; const unsigned qdst=lds0+LDS_Q+wid*4096;
    _Pragma("unroll") for(int i=0;i<4;++i) glds16nt(nq+i*16,(unsigned)__builtin_amdgcn_readfirstlane(qdst+i*1024)); }
  #undef UPD
  { float sacc=pB0[0]+pB0[1]; _Pragma("unroll") for(int r=2;r<16;++r)sacc+=pB0[r]; _Pragma("unroll") for(int r=0;r<16;++r)sacc+=pB1[r]; l_reg+=sacc;
    pw0=(u32x4){PKW(pB0,0),PKW(pB0,2),PKW(pB0,4),PKW(pB0,6)};pw1=(u32x4){PKW(pB0,8),PKW(pB0,10),PKW(pB0,12),PKW(pB0,14)};pw2=(u32x4){PKW(pB1,0),PKW(pB1,2),PKW(pB1,4),PKW(pB1,6)};pw3=(u32x4){PKW(pB1,8),PKW(pB1,10),PKW(pB1,12),PKW(pB1,14)};
    SBAR(); pv(o,vb0+sl_cur,PAF(0),PAF(1),PAF(2),PAF(3)); }
  #undef PKW
  #undef PAF
  #undef VFR
  #undef PIN
  #undef MX3
  #undef GAPA
  #undef GAPB
  #undef EX
  #undef VRD
  #undef KRD
  #undef STEP
  #undef ENDW
  {auto rr=__builtin_amdgcn_permlane32_swap(__float_as_uint(l_reg),__float_as_uint(l_reg),false,false);l_reg=__uint_as_float(rr[0])+__uint_as_float(rr[1]);}
  if(hi==0)wsf[32+r32]=l_reg;asm volatile("s_waitcnt lgkmcnt(0)":::"memory");
  float rli[16];
  #pragma unroll
  for(int r=0;r<16;++r)rli[r]=__builtin_amdgcn_rcpf(wsf[32+crow(r,hi)]);
  unsigned short*Mw=MIX+((long)(bh>>3)*SEQ+q0+wid*QBLK)*1024+512+(bh&7)*64;
  { bf16*stg=(bf16*)(shm+LDS_OST)+wid*2048;
    #pragma unroll
    for(int r=0;r<16;++r){const int orow=crow(r,hi);
      #pragma unroll
      for(int d0=0;d0<2;++d0){ bf16*sp_=stg+orow*64+d0*32+r32; *sp_=__float2bfloat16(o[d0][r]*rli[r]*__bfloat162float(*sp_)); } }
    asm volatile("s_waitcnt lgkmcnt(0)":::"memory");
    #pragma unroll
    for(int i=0;i<4;++i){const int row=i*8+(lane>>3),ch=lane&7; const u32x4 v=*(const u32x4*)(stg+row*64+ch*8); *(u32x4*)(Mw+(long)row*1024+ch*8)=v;} }
  asm volatile("s_waitcnt lgkmcnt(0)\n\ts_barrier":::"memory");
  #undef DMA_K
  #undef DMA_V
  #undef QL
  #undef TROW
  #undef CMASK
  #undef START
  #undef RESC
  #undef ROT
}
constexpr int MOBA_LDS_BYTES=LDS_BYTES;
#undef SBAR
#undef WAIT_BAR
#undef BFLO
#undef BFHI
}

struct Args { const float* x; const float* c; const int* pos; const float* pre_g; const float* post_g; const float* w_ada; const float* b_ada; const float* w_in; const float* w_out;
              float* out; unsigned char* ws; };
__constant__ float INV_FREQ[8] = {1.0f, 0.193922743f, 0.0376060307f, 0.00729266461f, 0.00141421356f, 0.000274248188f, 5.3182961e-05f, 1.03133862e-05f};

__global__ void __launch_bounds__(NWAVES * 64, 2) hymba_fwd(Args args) {
    extern __shared__ __attribute__((aligned(16))) unsigned char lds_raw[];
    LAS unsigned char* lds = (LAS unsigned char*)lds_raw;
    volatile LAS unsigned* MISC = (volatile LAS unsigned*)(lds + MISC_OFF);
    const int tid = threadIdx.x, lane = tid & 63, wave = __builtin_amdgcn_readfirstlane(tid >> 6);
    const int G = gridDim.x, bx = blockIdx.x;
    const int gw = bx * NWAVES + wave, NGW = G * NWAVES;
    unsigned char* ws = args.ws;
    gu32* ctl = (gu32*)(ws + WS_CTL);
    bf16* WinT = (bf16*)(ws + WS_WIN); bf16* WoutT = (bf16*)(ws + WS_WOUT);
    float* MOD = (float*)(ws + WS_MOD); _Float16* ROPE = (_Float16*)(ws + WS_ROPE); float* KM = (float*)(ws + WS_KM); float* LSE = (float*)(ws + WS_LSE);
    bf16* QKV = (bf16*)(ws + WS_QKV); bf16* Y = (bf16*)(ws + WS_Y); bf16* OP = (bf16*)(ws + WS_OP); bf16* H = (bf16*)(ws + WS_H); bf16* MIX = (bf16*)(ws + WS_MIX);
    for (int u = tid; u < (EPI_OFF - LDSCTL_OFF) / 4; u += NWAVES * 64) ((LAS unsigned*)(lds + LDSCTL_OFF))[u] = 0u;
    __syncthreads();
    XcdBarrier bar = xcd_barrier_post((unsigned*)(ctl + CW_BAR), MISC + 8);
    if (tid == 0) MISC[12] = __hip_atomic_fetch_add((unsigned*)(ctl + CW_RANK + 64 * bar.x), 1u, __ATOMIC_RELAXED, __HIP_MEMORY_SCOPE_AGENT);
#define GRID_BAR() do { XcdBarrier b2_ = bar; asm volatile("" : "+s"(b2_.x)); xcd_barrier(b2_); } while (0)
#define PHASE_IDS() int tid_o = threadIdx.x; asm volatile("" : "+v"(tid_o)); const int tid = tid_o, lane = tid & 63, wave = __builtin_amdgcn_readfirstlane(tid >> 6), gw = bx * NWAVES + wave; (void)gw; (void)lane

    for (int rep0_ = 0; rep0_ < REP_P0; ++rep0_) {
        LAS float* sc = (LAS float*)lds;
        LAS float* red = (LAS float*)(lds + 65536);
        if (bx < 192) {
            for (int i = tid; i < NB * DM; i += NWAVES * 64) { const float v = args.c[i]; sc[i] = v / (1.f + __expf(-v)); }
            __syncthreads();
            for (int item = bx; item < 192; item += G) {
                const int l = item / 96, e0 = (item % 96) * 32, el = tid & 31, dc = tid >> 5;
                float a[NB];
#pragma unroll
                for (int b = 0; b < NB; ++b) a[b] = 0.f;
                const float* wp = args.w_ada + (size_t)l * DM * 3072 + (size_t)(dc * 64) * 3072 + e0 + el;
                float w[64];
#pragma unroll
                for (int k = 0; k < 64; ++k) w[k] = __builtin_nontemporal_load(wp + (size_t)k * 3072);
#pragma unroll
                for (int bt = 0; bt < 4; ++bt) {
                    asm volatile("" : "+v"(w[bt * 16 + 0]), "+v"(w[bt * 16 + 1]), "+v"(w[bt * 16 + 2]), "+v"(w[bt * 16 + 3]), "+v"(w[bt * 16 + 4]), "+v"(w[bt * 16 + 5]), "+v"(w[bt * 16 + 6]), "+v"(w[bt * 16 + 7]),
                                        "+v"(w[bt * 16 + 8]), "+v"(w[bt * 16 + 9]), "+v"(w[bt * 16 + 10]), "+v"(w[bt * 16 + 11]), "+v"(w[bt * 16 + 12]), "+v"(w[bt * 16 + 13]), "+v"(w[bt * 16 + 14]), "+v"(w[bt * 16 + 15]));
#pragma unroll
                    for (int k4 = 0; k4 < 4; ++k4)
#pragma unroll
                        for (int b = 0; b < NB; ++b) { const f32x4 s4 = *(LAS const f32x4*)(sc + b * DM + dc * 64 + bt * 16 + k4 * 4);
                            a[b] += (s4.x * w[bt * 16 + 4 * k4] + s4.y * w[bt * 16 + 4 * k4 + 1]) + (s4.z * w[bt * 16 + 4 * k4 + 2] + s4.w * w[bt * 16 + 4 * k4 + 3]); }
                }
#pragma unroll
                for (int b = 0; b < NB; ++b) red[(dc * NB + b) * 32 + el] = a[b];
                __syncthreads();
                { const int b = tid >> 5; float s = 0.f;
#pragma unroll
                  for (int k = 0; k < 16; ++k) s += red[(k * NB + b) * 32 + el];
                  MOD[((size_t)l * NB + b) * 3072 + e0 + el] = s + args.b_ada[(size_t)l * 3072 + e0 + el]; }
                __syncthreads();
            }
        }
        else {
            LAS float* scr = (LAS float*)(lds + wave * 16384);
            constexpr int I_OUT = (DM / 64) * (DM / 32);
            for (int it = (bx - 192) * NWAVES + wave; it < DEPTH * I_OUT; it += (G - 192) * NWAVES) { const int l = it / I_OUT;
                p0_transpose_item(args.w_out + (size_t)l * DM * DM, DM, DM, WoutT + (size_t)l * DM * DM, 0, scr, it % I_OUT, lane); }
            for (int i = (bx - 192) * (NWAVES * 64) + tid; i < MROWS * 8; i += (G - 192) * NWAVES * 64) { const int row = i >> 3, f = i & 7;
                const float ang = (float)args.pos[row] * INV_FREQ[f];
                ROPE[(size_t)row * 16 + f] = (_Float16)cosf(ang); ROPE[(size_t)row * 16 + 8 + f] = (_Float16)sinf(ang); }
        }
    }
    GRID_BAR();
    if (tid == 0) { unsigned base = 0u; for (unsigned jx = 0; jx < bar.x; ++jx) base += xb_ld((unsigned*)(ctl + CW_BAR) + XB_XCNT(jx)); MISC[13] = base + MISC[12]; }
    __syncthreads();

    for (int rep1_ = 0; rep1_ < REP_P1; ++rep1_) {
        {
            LAS float* scr = (LAS float*)(lds + wave * 16384);
            constexpr int I_IN = (DM / 64) * (DIN / 32);
            for (int it = gw; it < DEPTH * I_IN; it += NGW) { const int l = it / I_IN;
                p0_transpose_item(args.w_in + (size_t)l * DM * DIN, DM, DIN, WinT + (size_t)l * DIN * DM, 0, scr, it % I_IN, lane); }
        }
        const int RPW = MROWS / NGW;
        const int row0 = (((bx % 8) * (G / 8) + bx / 8) * NWAVES + wave) * RPW, b = row0 / SEQ;
        const float* mod = MOD + (size_t)b * 3072;
        f32x4 A1[4], B1[4];
#pragma unroll
        for (int jj = 0; jj < 4; ++jj) { const int c = 4 * lane + 256 * jj; const f32x4 pg = *(const f32x4*)(args.pre_g + c), scl = *(const f32x4*)(mod + 1024 + c);
            A1[jj] = pg * (scl + 1.f); B1[jj] = *(const f32x4*)(mod + c); }
        for (int rg = row0; rg < row0 + RPW; rg += 4) {
            f32x4 v[4][4];
#pragma unroll
            for (int q = 0; q < 4; ++q) { const f32x4* xr = (const f32x4*)(args.x + (size_t)(rg + q) * DM) + lane;
#pragma unroll
                for (int jj = 0; jj < 4; ++jj) v[q][jj] = __builtin_nontemporal_load(xr + 64 * jj); }
#pragma unroll
            for (int q = 0; q < 4; ++q) { const int row = rg + q; float s = 0.f;
#pragma unroll
                for (int jj = 0; jj < 4; ++jj) s += (v[q][jj].x * v[q][jj].x + v[q][jj].y * v[q][jj].y) + (v[q][jj].z * v[q][jj].z + v[q][jj].w * v[q][jj].w);
                const float rstd = 1.f / sqrtf(wave_sum(s) * (1.f / DM) + RMS_EPS);
                unsigned long long* o8 = (unsigned long long*)(H + (size_t)row * DM) + lane;
#pragma unroll
                for (int jj = 0; jj < 4; ++jj) { const f32x4 hv = v[q][jj] * rstd * A1[jj] + B1[jj];
                    o8[64 * jj] = (unsigned long long)pk2(hv.x, hv.y) | ((unsigned long long)pk2(hv.z, hv.w) << 32); }
            }
        }
    }
    GRID_BAR();

    for (int layer = 0; layer < DEPTH; ++layer) {
        GAS unsigned char* wsl; { unsigned long long wsi_ = (unsigned long long)ws; asm volatile("" : "+s"(wsi_)); wsl = (GAS unsigned char*)wsi_; }
        int bxo_ = blockIdx.x; asm volatile("" : "+s"(bxo_)); const int bx = bxo_;
        bf16* WinT = (bf16*)(wsl + WS_WIN); bf16* WoutT = (bf16*)(wsl + WS_WOUT); float* MOD = (float*)(wsl + WS_MOD); _Float16* ROPE = (_Float16*)(wsl + WS_ROPE); float* KM = (float*)(wsl + WS_KM); float* LSE = (float*)(wsl + WS_LSE);
        bf16* QKV = (bf16*)(wsl + WS_QKV); bf16* Y = (bf16*)(wsl + WS_Y); bf16* OP = (bf16*)(wsl + WS_OP); bf16* H = (bf16*)(wsl + WS_H); bf16* MIX = (bf16*)(wsl + WS_MIX);
#ifndef SKIP_P2
        for (int rep_ = 0; rep_ < REP_P2; ++rep_) {
            pg8::Gemm g{H, WinT + (size_t)layer * DIN * DM, MROWS, DIN, DM}; pg8::StaticOrder S; S.init(MROWS, DIN, G, bx, 1);
            pg8::EpiProj E{QKV, ROPE, lds + EPI_OFF, lds + pg8::STAGE_BYTES};
            pg8::gemm_phase<pg8::EpiProj, pg8::StaticOrder, true, true>(lds, g, S, E);
        }
#endif
        GRID_BAR();
#ifndef SKIP_P3A
        for (int rep_ = 0; rep_ < REP_P3A; ++rep_) {
            PHASE_IDS();
            const int vcu = (int)__builtin_amdgcn_readfirstlane(MISC[13]);
            const int xg = (vcu >> 5) * 4 + ((vcu & 31) >> 3), mem = vcu & 7;
            att3::run_units<false>(8, [&](int k) { const int pi = (mem + 2 * (k >> 1)) & 7; return att3::make_unit((k >> 1) * 32 + xg, (int)((((k & 1) ? 0xFB754321u : 0xD96ECA80u) >> (4 * pi)) & 15u)); }, QKV, QKV + TSZ, QKV + 2 * TSZ, QKV + 3 * TSZ, OP, LSE, MIX, (LAS char*)lds);
            const bf16* KBp = QKV + 5 * TSZ;
            for (int t = gw; t < NB * NH * 8; t += NGW) {
                const int rg = lane >> 3, ch = lane & 7; float acc[8];
#pragma unroll
                for (int k = 0; k < 8; ++k) acc[k] = 0.f;
                const bf16* kp = KBp + ((size_t)t * 256 + rg) * 64 + ch * 8;
#pragma unroll 4
                for (int it = 0; it < 32; ++it) { const v4u w = *(const v4u*)(kp + (size_t)it * 8 * 64);
                    acc[0] += bflo(w.x); acc[1] += bfhi(w.x); acc[2] += bflo(w.y); acc[3] += bfhi(w.y); acc[4] += bflo(w.z); acc[5] += bfhi(w.z); acc[6] += bflo(w.w); acc[7] += bfhi(w.w); }
#pragma unroll
                for (int k = 0; k < 8; ++k) { acc[k] += __shfl_xor(acc[k], 8); acc[k] += __shfl_xor(acc[k], 16); acc[k] += __shfl_xor(acc[k], 32); }
                if (lane < 8) { float* o = KM + (size_t)t * 64 + ch * 8;
                    *(f32x4*)o = (f32x4){acc[0], acc[1], acc[2], acc[3]} * (1.f / 256.f); *(f32x4*)(o + 4) = (f32x4){acc[4], acc[5], acc[6], acc[7]} * (1.f / 256.f); }
            }
        }
#endif
        GRID_BAR();
#ifndef SKIP_P3B
        for (int rep_ = 0; rep_ < REP_P3B; ++rep_) {
            PHASE_IDS();
            const int vcu = (int)__builtin_amdgcn_readfirstlane(MISC[13]);
            const int xg = (vcu >> 5) * 4 + ((vcu & 31) >> 3), mem = vcu & 7;
            const int cpos = xg & 3;
            for (int ph = 0; ph < 5; ++ph) {
                if (ph == cpos) {
                    att3::run_units<true>(4, [&](int k) { return att3::make_unit(k * 32 + xg, 16 + mem); }, QKV, QKV + TSZ, QKV + 2 * TSZ, QKV + 3 * TSZ, OP, LSE, MIX, (LAS char*)lds);
                } else { const int k = ph - (ph > cpos); const int bh = k * 32 + xg;
                    auto jof = [&](int kk) { return (kk == 0) ? mem : (kk == 1) ? 7 - mem : (kk == 2) ? ((mem + 4) & 7) : 7 - ((mem + 4) & 7); };
                    const bool pre = (k > 0) && (k != cpos), nxt = (k + 1 < 4) && (k + 1 != cpos);
                    attb::moba_unit<8>(bh, jof(k), (const attb::bf16*)(QKV + 4 * TSZ), (const attb::bf16*)(QKV + 5 * TSZ), (const attb::bf16*)(QKV + 6 * TSZ), QKV + 7 * TSZ, KM, MIX, (char*)lds_raw, pre, (k + 1) * 32 + xg, nxt ? jof(k + 1) : -1); }
            }
        }
#endif
        GRID_BAR();
#ifndef SKIP_P4
        for (int rep_ = 0; rep_ < REP_P4; ++rep_) {
            pg8::Gemm g{MIX, WoutT + (size_t)layer * DM * DM, MROWS, DM, DM}; pg8::StaticOrder S; S.init(MROWS, DM, G, bx);
            pg8::EpiPlain E{Y, DM, lds + EPI_OFF};
            pg8::gemm_phase<pg8::EpiPlain, pg8::StaticOrder, true, true>(lds, g, S, E);
        }
#endif
        GRID_BAR();
#ifndef SKIP_P5
        for (int rep_ = 0; rep_ < REP_P5; ++rep_) {
            PHASE_IDS();
            const int RPW = MROWS / NGW; const int row0 = (((bx % 8) * (G / 8) + bx / 8) * NWAVES + wave) * RPW, b = row0 / SEQ;
            const float* mod = MOD + ((size_t)layer * NB + b) * 3072;
            const float* modn = MOD + ((size_t)(layer + 1 < DEPTH ? layer + 1 : layer) * NB + b) * 3072;
            const float* pgn = args.pre_g + (size_t)(layer + 1 < DEPTH ? layer + 1 : layer) * DM;
            const bool has_next = layer + 1 < DEPTH;
            bf16* X1B = (bf16*)(wsl + WS_X1B);
            f32x4 G2[4], A1[4], B1[4];
#pragma unroll
            for (int jj = 0; jj < 4; ++jj) { const int c = 4 * lane + 256 * jj;
                G2[jj] = *(const f32x4*)(mod + 2048 + c) * *(const f32x4*)(args.post_g + (size_t)layer * DM + c);
                A1[jj] = *(const f32x4*)(pgn + c) * (*(const f32x4*)(modn + 1024 + c) + 1.f); B1[jj] = *(const f32x4*)(modn + c); }
            for (int rg = row0; rg < row0 + RPW; rg += 4) {
                f32x4 xq[4][4]; v2u yq[4][4];
#pragma unroll
                for (int q = 0; q < 4; ++q) { const v2u* yr = (const v2u*)(Y + (size_t)(rg + q) * DM) + lane;
                    if (layer == 0) { const f32x4* xr = (const f32x4*)(args.x + (size_t)(rg + q) * DM) + lane;
#pragma unroll
                        for (int jj = 0; jj < 4; ++jj) xq[q][jj] = __builtin_nontemporal_load(xr + 64 * jj);
                    } else { const v2u* xr = (const v2u*)(X1B + (size_t)(rg + q) * DM) + lane;
#pragma unroll
                        for (int jj = 0; jj < 4; ++jj) { const v2u w = __builtin_nontemporal_load(xr + 64 * jj); xq[q][jj] = (f32x4){bflo(w.x), bfhi(w.x), bflo(w.y), bfhi(w.y)}; } }
#pragma unroll
                    for (int jj = 0; jj < 4; ++jj) yq[q][jj] = __builtin_nontemporal_load(yr + 64 * jj); }
#pragma unroll
                for (int q = 0; q < 4; ++q) { const int row = rg + q;
                    f32x4 xv[4], yv[4]; float s = 0.f;
#pragma unroll
                    for (int jj = 0; jj < 4; ++jj) { xv[jj] = xq[q][jj]; const v2u w = yq[q][jj]; yv[jj] = (f32x4){bflo(w.x), bfhi(w.x), bflo(w.y), bfhi(w.y)};
                        s += (yv[jj].x * yv[jj].x + yv[jj].y * yv[jj].y) + (yv[jj].z * yv[jj].z + yv[jj].w * yv[jj].w); }
                    const float rstd = 1.f / sqrtf(wave_sum(s) * (1.f / DM) + RMS_EPS);
                    float s2 = 0.f;
                    f32x4* orow = (f32x4*)(args.out + (size_t)row * DM) + lane; v2u* xrow = (v2u*)(X1B + (size_t)row * DM) + lane;
#pragma unroll
                    for (int jj = 0; jj < 4; ++jj) { xv[jj] = xv[jj] + G2[jj] * (yv[jj] * rstd);
                        if (has_next) __builtin_nontemporal_store((v2u){pk2(xv[jj].x, xv[jj].y), pk2(xv[jj].z, xv[jj].w)}, xrow + 64 * jj); else __builtin_nontemporal_store(xv[jj], orow + 64 * jj);
                        s2 += (xv[jj].x * xv[jj].x + xv[jj].y * xv[jj].y) + (xv[jj].z * xv[jj].z + xv[jj].w * xv[jj].w); }
                    if (has_next) {
                        const float rstd2 = 1.f / sqrtf(wave_sum(s2) * (1.f / DM) + RMS_EPS);
                        unsigned long long* o8 = (unsigned long long*)(H + (size_t)row * DM) + lane;
#pragma unroll
                        for (int jj = 0; jj < 4; ++jj) { const f32x4 hv = xv[jj] * rstd2 * A1[jj] + B1[jj];
                            o8[64 * jj] = (unsigned long long)pk2(hv.x, hv.y) | ((unsigned long long)pk2(hv.z, hv.w) << 32); }
                    }
                }
            }
        }
#endif
        if (layer + 1 < DEPTH) GRID_BAR();
    }
}

extern "C" void kernel_launch(void* const* d_in, const int* in_sizes, int n_in, void* d_out, int out_size, void* d_ws, size_t ws_size, hipStream_t stream) {
    static int grid = 0;
    if (grid == 0) {
        if (n_in != 9 || in_sizes[0] != MROWS * DM || out_size != MROWS * DM || ws_size < WS_END) { fprintf(stderr, "kernel_launch: unexpected problem shape (n_in %d, ws %zu)\n", n_in, ws_size); grid = -1; return; }
        int dev = 0, cus = 0, per_cu = 0;
        if (hipGetDevice(&dev) != hipSuccess || hipDeviceGetAttribute(&cus, hipDeviceAttributeMultiprocessorCount, dev) != hipSuccess) { grid = -1; return; }
        if (hipFuncSetAttribute((const void*)hymba_fwd, hipFuncAttributeMaxDynamicSharedMemorySize, LDS_BYTES) != hipSuccess) { fprintf(stderr, "kernel_launch: hipFuncSetAttribute failed\n"); grid = -1; return; }
        if (hipOccupancyMaxActiveBlocksPerMultiprocessor(&per_cu, (const void*)hymba_fwd, NWAVES * 64, LDS_BYTES) != hipSuccess || per_cu < 1) { fprintf(stderr, "kernel_launch: occupancy query reports %d\n", per_cu); }
        (void)hipGetLastError();
        grid = cus;
        if (grid != 256) { fprintf(stderr, "kernel_launch: built for a 256-CU device, found %d CUs\n", cus); grid = -1; return; }
    }
    if (grid < 0) return;
    if (hipMemsetAsync((char*)d_ws + WS_CTL, 0, CTL_ZERO_BYTES, stream) != hipSuccess) return;
    Args a{};
    a.x = (const float*)d_in[0]; a.c = (const float*)d_in[1]; a.pos = (const int*)d_in[2]; a.pre_g = (const float*)d_in[3]; a.post_g = (const float*)d_in[4];
    a.w_ada = (const float*)d_in[5]; a.b_ada = (const float*)d_in[6]; a.w_in = (const float*)d_in[7]; a.w_out = (const float*)d_in[8];
    a.out = (float*)d_out; a.ws = (unsigned char*)d_ws;
    hipLaunchKernelGGL(hymba_fwd, dim3(grid), dim3(NWAVES * 64), LDS_BYTES, stream, a);
}
```
